# Optimizing an MI355X kernel written in HIP

```python
import math
import jax
import jax.numpy as jnp
from jax import lax
import numpy as np

D_MODEL = 1024
BATCH = 8
SEQ = 2048
DEPTH = 2

GLA_HEADS = 4
GLA_DK = 64
GLA_DV = 128
GLA_GATE_RANK = 16
GLA_GATE_TEMP = 16.0
GLA_CHUNK = 64
DIFF_HEADS = 4
DIFF_DK = 64
DIFF_DV = 128
N_BUCKETS = 32
MAX_DISTANCE = 128
MLA_HEADS = 16
MLA_Q_LORA = 256
MLA_KV_LORA = 128
MLA_NOPE = 64
MLA_ROPE = 32
MLA_DV = 64
ROPE_THETA = 10000.0
D_FF = 2816
N_EXPERTS = 8
TOP_K = 2
Q_BLOCK = 128
DEEPNORM_ALPHA = (2 * DEPTH) ** 0.25
DEEPNORM_BETA = (8 * DEPTH) ** -0.25
N_EVEN = (DEPTH + 1) // 2
N_ODD = DEPTH // 2
EVEN_IN_WIDTHS = (GLA_HEADS * GLA_DK, GLA_HEADS * GLA_DK, GLA_HEADS * GLA_DV, GLA_HEADS * GLA_DV,
                  2 * GLA_GATE_RANK,
                  DIFF_HEADS * 2 * DIFF_DK, DIFF_HEADS * 2 * DIFF_DK, DIFF_HEADS * DIFF_DV)
EVEN_IN = sum(EVEN_IN_WIDTHS)
EVEN_OUT = GLA_HEADS * GLA_DV + DIFF_HEADS * DIFF_DV
ODD_IN = MLA_Q_LORA + MLA_KV_LORA + MLA_ROPE
ODD_OUT = MLA_HEADS * MLA_DV

kernel_name = 'hybrid_gla_diff_mla_moe_encoder'


def _split_widths(t, widths):
    idx, acc = [], 0
    for w in widths[:-1]:
        acc += w
        idx.append(acc)
    return jnp.split(t, idx, axis=-1)


def _layer_norm(x, g, b, eps=1e-5):
    xf = x.astype(jnp.float32)
    mu = jnp.mean(xf, axis=-1, keepdims=True)
    var = jnp.mean(jnp.square(xf - mu), axis=-1, keepdims=True)
    y = (xf - mu) * lax.rsqrt(var + eps) * g.astype(jnp.float32) + b.astype(jnp.float32)
    return y.astype(x.dtype)


def _rms_norm(x, g, eps=1e-6):
    xf = x.astype(jnp.float32)
    y = xf * lax.rsqrt(jnp.mean(jnp.square(xf), axis=-1, keepdims=True) + eps) * g.astype(jnp.float32)
    return y.astype(x.dtype)


def _rope(t, positions):
    half = t.shape[-1] // 2
    inv = ROPE_THETA ** (-jnp.arange(half, dtype=jnp.float32) / half)
    ang = positions.astype(jnp.float32)[:, None] * inv[None, :]
    cos, sin = jnp.cos(ang), jnp.sin(ang)
    tf = t.astype(jnp.float32)
    t1, t2 = tf[..., :half], tf[..., half:]
    return jnp.concatenate([t1 * cos - t2 * sin, t1 * sin + t2 * cos], axis=-1).astype(t.dtype)


def _relative_bucket(rel):
    half = N_BUCKETS // 2
    max_exact = half // 2
    bucket = jnp.where(rel > 0, half, 0).astype(jnp.int32)
    n = jnp.abs(rel)
    n_large = max_exact + (jnp.log(jnp.maximum(n, max_exact).astype(jnp.float32) / max_exact)
                           / math.log(MAX_DISTANCE / max_exact) * (half - max_exact)).astype(jnp.int32)
    n_large = jnp.minimum(n_large, half - 1)
    return bucket + jnp.where(n < max_exact, n, n_large)


def _block_softmax_attention(q, k, v, map_weights, bias_table):
    B, H, M, S, dq = q.shape
    dv = v.shape[-1]
    nb = S // Q_BLOCK
    scale = dq ** -0.5
    q_blocks = jnp.moveaxis(q.reshape(B, H, M, nb, Q_BLOCK, dq), 3, 0)
    starts = jnp.arange(nb, dtype=jnp.int32) * Q_BLOCK
    k_pos = jnp.arange(S, dtype=jnp.int32)
    mw = map_weights.astype(jnp.float32)

    def one_block(args):
        qb, start = args
        s = jnp.einsum('bhmqd,bhmkd->bhmqk', qb, k).astype(jnp.float32) * scale
        if bias_table is not None:
            q_pos = start + jnp.arange(Q_BLOCK, dtype=jnp.int32)
            bucket = _relative_bucket(k_pos[None, :] - q_pos[:, None])
            bias = jnp.moveaxis(bias_table[bucket], -1, 0).astype(jnp.float32)
            s = s + bias[None, :, None]
        p = jax.nn.softmax(s, axis=-1)
        a = jnp.einsum('m,bhmqk->bhqk', mw, p)
        return jnp.einsum('bhqk,bhkd->bhqd', a.astype(v.dtype), v)

    out = lax.map(one_block, (q_blocks, starts))
    return jnp.moveaxis(out, 0, 2).reshape(B, H, S, dv)


def _gla_chunked(q, k, v, log_a):
    out_dtype = v.dtype
    B, H, S, dk = q.shape
    dv = v.shape[-1]
    n = S // GLA_CHUNK
    C = GLA_CHUNK
    q = q.astype(jnp.float32).reshape(B, H, n, C, dk)
    k = k.astype(jnp.float32).reshape(B, H, n, C, dk)
    v = v.astype(jnp.float32).reshape(B, H, n, C, dv)
    b = jnp.cumsum(log_a.astype(jnp.float32).reshape(B, H, n, C, dk), axis=3)
    b_last = b[:, :, :, -1:, :]
    q_dec = q * jnp.exp(b)
    mask = jnp.tril(jnp.ones((C, C), jnp.float32))
    attn = jnp.einsum('bhnid,bhnjd->bhnij', q_dec, k * jnp.exp(-b)) * mask
    o_intra = jnp.einsum('bhnij,bhnjv->bhniv', attn, v)
    chunk_kv = jnp.einsum('bhnjd,bhnjv->bhndv', k * jnp.exp(b_last - b), v)
    decay = jnp.exp(b_last[:, :, :, 0, :])

    def step(state, inp):
        dec, kv = inp
        return dec[..., None] * state + kv, state

    init = jnp.zeros((B, H, dk, dv), jnp.float32)
    _, s_before = lax.scan(step, init, (jnp.moveaxis(decay, 2, 0), jnp.moveaxis(chunk_kv, 2, 0)))
    s_before = jnp.moveaxis(s_before, 0, 2)
    o_inter = jnp.einsum('bhnid,bhndv->bhniv', q_dec, s_before)
    return (o_intra + o_inter).reshape(B, H, S, dv).astype(out_dtype)


def _even_mixer(x, w_in, gate_up, gate_bias, gla_gain, diff_lambda, diff_gain, w_out, rel_bias_table, lam_init):
    B, S, _ = x.shape
    q_g, k_g, v_g, g_g, a_lr, q_d, k_d, v_d = _split_widths(x @ w_in, EVEN_IN_WIDTHS)

    def heads(t, h, d):
        return t.reshape(B, S, h, d).transpose(0, 2, 1, 3)

    qg = heads(q_g, GLA_HEADS, GLA_DK) * (GLA_DK ** -0.5)
    kg = heads(k_g, GLA_HEADS, GLA_DK)
    vg = heads(v_g, GLA_HEADS, GLA_DV)
    a_lr = a_lr.reshape(B, S, 2, GLA_GATE_RANK)
    gate_logits = jnp.einsum('bsdr,drk->dbsk', a_lr, gate_up) + gate_bias[:, None, None, :]
    log_a = jax.nn.log_sigmoid(gate_logits.astype(jnp.float32)) / GLA_GATE_TEMP
    la_f = heads(log_a[0], GLA_HEADS, GLA_DK)
    la_b = heads(log_a[1], GLA_HEADS, GLA_DK)
    o_f = _gla_chunked(qg, kg, vg, la_f)
    flip = lambda t: jnp.flip(t, axis=2)
    o_b = flip(_gla_chunked(flip(qg), flip(kg), flip(vg), flip(la_b)))
    o_gla = _rms_norm(o_f + o_b, gla_gain)
    o_gla = o_gla.transpose(0, 2, 1, 3).reshape(B, S, GLA_HEADS * GLA_DV) * jax.nn.silu(g_g)

    qd = q_d.reshape(B, S, DIFF_HEADS, 2, DIFF_DK).transpose(0, 2, 3, 1, 4)
    kd = k_d.reshape(B, S, DIFF_HEADS, 2, DIFF_DK).transpose(0, 2, 3, 1, 4)
    vd = heads(v_d, DIFF_HEADS, DIFF_DV)
    lf = diff_lambda.astype(jnp.float32)
    lam = jnp.exp(jnp.sum(lf[0] * lf[1])) - jnp.exp(jnp.sum(lf[2] * lf[3])) + lam_init
    map_w = jnp.stack([jnp.ones((), jnp.float32), -lam])
    o_d = _block_softmax_attention(qd, kd, vd, map_w, rel_bias_table)
    o_d = _rms_norm(o_d, diff_gain) * (1.0 - lam_init)
    o_diff = o_d.transpose(0, 2, 1, 3).reshape(B, S, DIFF_HEADS * DIFF_DV)

    return jnp.concatenate([o_gla, o_diff], axis=-1) @ w_out


def _mla_mixer(x, w_in, q_gain, kv_gain, w_uq, w_ukv, w_out):
    B, S, _ = x.shape
    c_q, c_kv, k_r = _split_widths(x @ w_in, (MLA_Q_LORA, MLA_KV_LORA, MLA_ROPE))
    q = (_rms_norm(c_q, q_gain) @ w_uq).reshape(B, S, MLA_HEADS, MLA_NOPE + MLA_ROPE).transpose(0, 2, 1, 3)
    kv = (_rms_norm(c_kv, kv_gain) @ w_ukv).reshape(B, S, MLA_HEADS, MLA_NOPE + MLA_DV).transpose(0, 2, 1, 3)
    pos = jnp.arange(S, dtype=jnp.int32)
    q = jnp.concatenate([q[..., :MLA_NOPE], _rope(q[..., MLA_NOPE:], pos)], axis=-1)
    k_rope = jnp.broadcast_to(_rope(k_r, pos)[:, None], (B, MLA_HEADS, S, MLA_ROPE))
    k = jnp.concatenate([kv[..., :MLA_NOPE], k_rope], axis=-1)
    v = kv[..., MLA_NOPE:]
    o = _block_softmax_attention(q[:, :, None], k[:, :, None], v, jnp.ones((1,), jnp.float32), None)
    return o.transpose(0, 2, 1, 3).reshape(B, S, ODD_OUT) @ w_out


def _swiglu(x, w_gate, w_up, w_down):
    return (jax.nn.silu(x @ w_gate) * (x @ w_up)) @ w_down


def _moe_swiglu(x, router_w, w_gate, w_up, w_down):
    B, S, D = x.shape
    t = x.reshape(B * S, D)
    logits = (t @ router_w).astype(jnp.float32)
    top_vals, top_idx = lax.top_k(logits, TOP_K)
    w = jax.nn.softmax(top_vals, axis=-1)
    combine = jnp.einsum('nk,nke->ne', w, jax.nn.one_hot(top_idx, N_EXPERTS, dtype=jnp.float32))
    out = jnp.zeros_like(t)
    for e in range(N_EXPERTS):
        out = out + combine[:, e:e + 1].astype(t.dtype) * _swiglu(t, w_gate[e], w_up[e], w_down[e])
    return out.reshape(B, S, D)


def setup_inputs(seed: int = 0) -> dict:
    key = jax.random.key(seed)
    ks = iter(jax.random.split(key, 32))

    def dense(shape, fan_in, scale=1.0):
        return jax.random.normal(next(ks), shape, jnp.float32) * (scale * fan_in ** -0.5)

    def gain(shape):
        return 1.0 + 0.02 * jax.random.normal(next(ks), shape, jnp.float32)

    def small(shape, s):
        return s * jax.random.normal(next(ks), shape, jnp.float32)

    beta = DEEPNORM_BETA
    return {
        'x': jax.random.normal(next(ks), (BATCH, SEQ, D_MODEL), jnp.float32),
        'rel_bias_table': small((N_BUCKETS, DIFF_HEADS), 0.5),
        'even_w_in': dense((N_EVEN, D_MODEL, EVEN_IN), D_MODEL),
        'gla_gate_up': dense((N_EVEN, 2, GLA_GATE_RANK, GLA_HEADS * GLA_DK), GLA_GATE_RANK),
        'gla_gate_bias': small((N_EVEN, 2, GLA_HEADS * GLA_DK), 0.1),
        'gla_norm_gain': gain((N_EVEN, GLA_DV)),
        'diff_lambda': small((N_EVEN, 4, DIFF_DK), 0.1),
        'diff_norm_gain': gain((N_EVEN, DIFF_DV)),
        'even_w_out': dense((N_EVEN, EVEN_OUT, D_MODEL), EVEN_OUT, beta),
        'ffn_w_gate': dense((N_EVEN, D_MODEL, D_FF), D_MODEL),
        'ffn_w_up': dense((N_EVEN, D_MODEL, D_FF), D_MODEL),
        'ffn_w_down': dense((N_EVEN, D_FF, D_MODEL), D_FF, beta),
        'odd_w_in': dense((N_ODD, D_MODEL, ODD_IN), D_MODEL),
        'mla_q_norm_gain': gain((N_ODD, MLA_Q_LORA)),
        'mla_kv_norm_gain': gain((N_ODD, MLA_KV_LORA)),
        'mla_w_uq': dense((N_ODD, MLA_Q_LORA, MLA_HEADS * (MLA_NOPE + MLA_ROPE)), MLA_Q_LORA),
        'mla_w_ukv': dense((N_ODD, MLA_KV_LORA, MLA_HEADS * (MLA_NOPE + MLA_DV)), MLA_KV_LORA),
        'odd_w_out': dense((N_ODD, ODD_OUT, D_MODEL), ODD_OUT, beta),
        'router_w': dense((N_ODD, D_MODEL, N_EXPERTS), D_MODEL),
        'moe_w_gate': dense((N_ODD, N_EXPERTS, D_MODEL, D_FF), D_MODEL),
        'moe_w_up': dense((N_ODD, N_EXPERTS, D_MODEL, D_FF), D_MODEL),
        'moe_w_down': dense((N_ODD, N_EXPERTS, D_FF, D_MODEL), D_FF, beta),
        'ln_gain': gain((DEPTH, 2, D_MODEL)),
        'ln_bias': small((DEPTH, 2, D_MODEL), 0.02),
    }


def reference(x, rel_bias_table, even_w_in, gla_gate_up, gla_gate_bias, gla_norm_gain, diff_lambda,
              diff_norm_gain, even_w_out, ffn_w_gate, ffn_w_up, ffn_w_down, odd_w_in, mla_q_norm_gain,
              mla_kv_norm_gain, mla_w_uq, mla_w_ukv, odd_w_out, router_w, moe_w_gate, moe_w_up, moe_w_down,
              ln_gain, ln_bias):
    for layer in range(DEPTH):
        i = layer // 2
        if layer % 2 == 0:
            lam_init = 0.8 - 0.6 * math.exp(-0.3 * layer)
            h = _even_mixer(x, even_w_in[i], gla_gate_up[i], gla_gate_bias[i], gla_norm_gain[i],
                            diff_lambda[i], diff_norm_gain[i], even_w_out[i], rel_bias_table, lam_init)
            x = _layer_norm(DEEPNORM_ALPHA * x + h, ln_gain[layer, 0], ln_bias[layer, 0])
            f = _swiglu(x, ffn_w_gate[i], ffn_w_up[i], ffn_w_down[i])
        else:
            h = _mla_mixer(x, odd_w_in[i], mla_q_norm_gain[i], mla_kv_norm_gain[i], mla_w_uq[i],
                           mla_w_ukv[i], odd_w_out[i])
            x = _layer_norm(DEEPNORM_ALPHA * x + h, ln_gain[layer, 0], ln_bias[layer, 0])
            f = _moe_swiglu(x, router_w[i], moe_w_gate[i], moe_w_up[i], moe_w_down[i])
        x = _layer_norm(DEEPNORM_ALPHA * x + f, ln_gain[layer, 1], ln_bias[layer, 1])
    return x
```

```cpp
#include <hip/hip_runtime.h>
#include <cstdio>
#include <cstdint>
namespace pg8 {
#define PG8_LAS __attribute__((address_space(3)))
typedef unsigned short bf16_t;
typedef short bf16x8 __attribute__((ext_vector_type(8)));
typedef float f32x4 __attribute__((ext_vector_type(4)));
typedef unsigned u32x4 __attribute__((ext_vector_type(4)));
constexpr int BM = 256, BK = 64, HALF = 128, HTB = HALF * BK * 2  , STAGE_BYTES = 8 * HTB, NXCD = 8, WGM = 8;

__host__ __device__ __forceinline__ int lds_byte(int r, int c) { const int st = (r >> 4) * 2 + (c >> 5), rr = r & 15, cc = c & 31, ob = rr * 64 + cc * 2; return st * 1024 + (ob ^ (((ob >> 9) & 1) << 5)); }
__host__ __device__ __forceinline__ void stage_rc(int b, int& R, int& C) { const int st = b / 1024, sb = b % 1024, swz = sb ^ (((sb >> 9) & 1) << 5); R = (st >> 1) * 16 + swz / 64; C = (st & 1) * 32 + (swz % 64) / 2; }
__host__ __device__ __forceinline__ int perm32(int rho) { const int n = rho >> 4, i = rho & 15; return 8 * (i >> 2) + 4 * n + (i & 3); }

struct Unit { int pm, pn; };
struct Gemm { const bf16_t* A; const bf16_t* Bt; int M, N, K; };

struct StaticOrder {
    int nM, nN, nwg, G, c;
    __host__ __device__ void init(int M, int N, int G_, int c_) { nM = M / BM; nN = N / BM; nwg = nM * nN; G = G_; c = c_; }
    __host__ __device__ bool next(int i, Unit& u) const {
        const long L = (long)i * G + c; if (L >= nwg) return false;
        int wgid = (int)L; { const int q = nwg / NXCD, r = nwg % NXCD, xcd = wgid % NXCD, off = wgid / NXCD; wgid = (xcd < r ? xcd * (q + 1) : r * (q + 1) + (xcd - r) * q) + off; }
        const int nig = WGM * nN, gid = wgid / nig, fm = gid * WGM, gsz = (nM - fm) < WGM ? (nM - fm) : WGM;
        u.pm = fm + ((wgid % nig) % gsz); u.pn = (wgid % nig) / gsz; return true;
    }
    __device__ __forceinline__ void a_ready(const Unit&) const {}
    __device__ __forceinline__ void done(const Unit&) const {}
};

__device__ __forceinline__ unsigned cvt_pk_bf16(float lo, float hi) { unsigned r; asm volatile("v_cvt_pk_bf16_f32 %0, %1, %2" : "=v"(r) : "v"(lo), "v"(hi)); return r; }
typedef float f32x2 __attribute__((ext_vector_type(2)));
typedef unsigned u32x2 __attribute__((ext_vector_type(2)));
__device__ __forceinline__ unsigned f2bf_rne(float f) { unsigned u = __builtin_bit_cast(unsigned, f); return (u + 0x7fffu + ((u >> 16) & 1u)) >> 16; }
__device__ __forceinline__ float silu_f(float g) { return g * __builtin_amdgcn_rcpf(1.0f + __expf(-g)); }
__device__ __forceinline__ u32x4 pack8(const f32x4 v0, const f32x4 v1) { u32x4 w; w.x = cvt_pk_bf16(v0[0], v0[1]); w.y = cvt_pk_bf16(v0[2], v0[3]); w.z = cvt_pk_bf16(v1[0], v1[1]); w.w = cvt_pk_bf16(v1[2], v1[3]); return w; }

struct EpiEvenIn {
    static constexpr bool PERM = true, AFTER_DRAIN = false;
    bf16_t *QG, *KG, *VG, *GG, *QD, *KD, *VDT; float* ALR;
    __device__ __forceinline__ void operator()(const f32x4 (&acc)[2][2][4][2], const Unit& u, int wr, int wc, int fr, int fq) const {
        const int pn = u.pn; const int row0 = u.pm * BM + wr * 64 + fr; const int cl = wc * 32 + 8 * fq;
        if (pn < 10) {
            bf16_t* base; int ld, c0; float sc = 1.f;
            if (pn == 0) { base = QG; ld = 256; c0 = 0; sc = 0.125f; }
            else if (pn == 1) { base = KG; ld = 256; c0 = 0; }
            else if (pn < 4) { base = VG; ld = 512; c0 = (pn - 2) * 256; }
            else if (pn < 6) { base = GG; ld = 512; c0 = (pn - 4) * 256; }
            else if (pn < 8) { base = QD; ld = 512; c0 = (pn - 6) * 256; sc = 0.125f * 1.4426950408889634f; }
            else { base = KD; ld = 512; c0 = (pn - 8) * 256; }
#pragma unroll
            for (int ai = 0; ai < 2; ++ai)
#pragma unroll
                for (int m = 0; m < 4; ++m) { bf16_t* rowp = base + (size_t)(row0 + ai * HALF + m * 16) * ld + c0 + cl;
#pragma unroll
                    for (int bj = 0; bj < 2; ++bj) *(u32x4*)(rowp + bj * HALF) = pack8(acc[ai][bj][m][0] * sc, acc[ai][bj][m][1] * sc); }
        } else if (pn < 12) {
            const int b = row0 >> 11, s0 = row0 & 2047;
#pragma unroll
            for (int bj = 0; bj < 2; ++bj) { bf16_t* vp0 = VDT + ((size_t)(b * 4 + 2 * (pn - 10) + bj) * 128 + cl) * 2048 + s0;
#pragma unroll
                for (int n = 0; n < 2; ++n)
#pragma unroll
                    for (int e = 0; e < 4; ++e) { bf16_t* vp = vp0 + (size_t)(4 * n + e) * 2048;
#pragma unroll
                        for (int ai = 0; ai < 2; ++ai)
#pragma unroll
                            for (int m = 0; m < 4; ++m) vp[ai * HALF + m * 16] = (bf16_t)f2bf_rne(acc[ai][bj][m][n][e]); } }
        } else {
            if (wc == 0) {
#pragma unroll
                for (int ai = 0; ai < 2; ++ai)
#pragma unroll
                    for (int m = 0; m < 4; ++m) { float* rowp = ALR + (size_t)(row0 + ai * HALF + m * 16) * 32 + 8 * fq; *(f32x4*)rowp = acc[ai][0][m][0]; *(f32x4*)(rowp + 4) = acc[ai][0][m][1]; }
            }
        }
    }
};
struct EpiResid {
    static constexpr bool PERM = false, AFTER_DRAIN = false;
    const float* base; float* out; float alpha;
    __device__ __forceinline__ void operator()(const f32x4 (&acc)[2][2][4][2], const Unit& u, int wr, int wc, int fr, int fq) const {
        const int col0 = u.pn * BM + wc * 32 + 4 * fq;
#pragma unroll
        for (int ai = 0; ai < 2; ++ai)
#pragma unroll
            for (int m = 0; m < 4; ++m) { const size_t off = (size_t)(u.pm * BM + ai * HALF + wr * 64 + m * 16 + fr) * 1024 + col0;
#pragma unroll
                for (int bj = 0; bj < 2; ++bj)
#pragma unroll
                    for (int n = 0; n < 2; ++n) { const size_t p = off + bj * HALF + n * 16; const f32x4 bs = *(const f32x4*)(base + p); *(f32x4*)(out + p) = bs * alpha + acc[ai][bj][m][n]; } }
    }
};
struct EpiSwiglu {
    static constexpr bool PERM = true, AFTER_DRAIN = false;
    bf16_t* H; int ncol, pm_off;
    __device__ __forceinline__ void operator()(const f32x4 (&acc)[2][2][4][2], const Unit& u, int wr, int wc, int fr, int fq) const {
        const int pnl = u.pn % ncol; const int rowb = (u.pm - pm_off) * BM + wr * 64 + fr; const int col = pnl * 128 + wc * 32 + 8 * fq;
#pragma unroll
        for (int ai = 0; ai < 2; ++ai)
#pragma unroll
            for (int m = 0; m < 4; ++m) { bf16_t* rowp = H + (size_t)(rowb + ai * HALF + m * 16) * 2816 + col;
                f32x4 h0, h1;
#pragma unroll
                for (int e = 0; e < 4; ++e) { h0[e] = silu_f(acc[ai][0][m][0][e]) * acc[ai][1][m][0][e]; h1[e] = silu_f(acc[ai][0][m][1][e]) * acc[ai][1][m][1][e]; }
                *(u32x4*)rowp = pack8(h0, h1); }
    }
};
struct EpiBf16Out {
    static constexpr bool PERM = true, AFTER_DRAIN = false;
    bf16_t* Y; int pm_add;
    __device__ __forceinline__ void operator()(const f32x4 (&acc)[2][2][4][2], const Unit& u, int wr, int wc, int fr, int fq) const {
        const int pnl = u.pn & 3; const int rowb = (u.pm + pm_add) * BM + wr * 64 + fr; const int col = pnl * BM + wc * 32 + 8 * fq;
#pragma unroll
        for (int ai = 0; ai < 2; ++ai)
#pragma unroll
            for (int m = 0; m < 4; ++m) { bf16_t* rowp = Y + (size_t)(rowb + ai * HALF + m * 16) * 1024 + col;
#pragma unroll
                for (int bj = 0; bj < 2; ++bj) *(u32x4*)(rowp + bj * HALF) = pack8(acc[ai][bj][m][0], acc[ai][bj][m][1]); }
    }
};
struct EpiOddIn {
    static constexpr bool PERM = false, AFTER_DRAIN = false;
    float *CQ, *CKV, *KR;
    __device__ __forceinline__ void operator()(const f32x4 (&acc)[2][2][4][2], const Unit& u, int wr, int wc, int fr, int fq) const {
        const size_t row0 = (size_t)(u.pm * BM + wr * 64 + fr);
        if (u.pn == 0) {
#pragma unroll
            for (int ai = 0; ai < 2; ++ai)
#pragma unroll
                for (int m = 0; m < 4; ++m)
#pragma unroll
                    for (int bj = 0; bj < 2; ++bj)
#pragma unroll
                        for (int n = 0; n < 2; ++n) *(f32x4*)(CQ + (row0 + ai * HALF + m * 16) * 256 + bj * HALF + wc * 32 + n * 16 + 4 * fq) = acc[ai][bj][m][n];
        } else {
#pragma unroll
            for (int ai = 0; ai < 2; ++ai)
#pragma unroll
                for (int m = 0; m < 4; ++m)
#pragma unroll
                    for (int n = 0; n < 2; ++n) *(f32x4*)(CKV + (row0 + ai * HALF + m * 16) * 128 + wc * 32 + n * 16 + 4 * fq) = acc[ai][0][m][n];
            if (wc == 0) {
#pragma unroll
                for (int ai = 0; ai < 2; ++ai)
#pragma unroll
                    for (int m = 0; m < 4; ++m)
#pragma unroll
                        for (int n = 0; n < 2; ++n) *(f32x4*)(KR + (row0 + ai * HALF + m * 16) * 32 + n * 16 + 4 * fq) = acc[ai][1][m][n];
            }
        }
    }
};
struct EpiQUp {
    static constexpr bool PERM = false, AFTER_DRAIN = false;
    bf16_t* Q; const float* rope; float qs;
    __device__ __forceinline__ void operator()(const f32x4 (&acc)[2][2][4][2], const Unit& u, int wr, int wc, int fr, int fq) const {
        const int row0 = u.pm * BM + wr * 64 + fr;
#pragma unroll
        for (int bj = 0; bj < 2; ++bj) { const int G = u.pn * 8 + bj * 4 + wc; bf16_t* colp = Q + G * 32 + 4 * fq;
            if ((G % 3) != 2) {
#pragma unroll
                for (int ai = 0; ai < 2; ++ai)
#pragma unroll
                    for (int m = 0; m < 4; ++m) { bf16_t* rowp = colp + (size_t)(row0 + ai * HALF + m * 16) * 1536;
                        const f32x4 a0 = acc[ai][bj][m][0] * qs, a1 = acc[ai][bj][m][1] * qs;
                        u32x2 w0, w1; w0.x = cvt_pk_bf16(a0[0], a0[1]); w0.y = cvt_pk_bf16(a0[2], a0[3]); w1.x = cvt_pk_bf16(a1[0], a1[1]); w1.y = cvt_pk_bf16(a1[2], a1[3]);
                        *(u32x2*)rowp = w0; *(u32x2*)(rowp + 16) = w1; }
            } else {
#pragma unroll
                for (int ai = 0; ai < 2; ++ai)
#pragma unroll
                    for (int m = 0; m < 4; ++m) { const int row = row0 + ai * HALF + m * 16; bf16_t* rowp = colp + (size_t)row * 1536;
                        const int pos = row & 2047; const f32x4* rp = (const f32x4*)(rope + (size_t)pos * 32 + 8 * fq); const f32x4 t0 = rp[0], t1 = rp[1];
                        const f32x4 cs = (f32x4){t0[0], t0[2], t1[0], t1[2]} * qs, sn = (f32x4){t0[1], t0[3], t1[1], t1[3]} * qs;
                        const f32x4 a0 = acc[ai][bj][m][0] * cs - acc[ai][bj][m][1] * sn, a1 = acc[ai][bj][m][0] * sn + acc[ai][bj][m][1] * cs;
                        u32x2 w0, w1; w0.x = cvt_pk_bf16(a0[0], a0[1]); w0.y = cvt_pk_bf16(a0[2], a0[3]); w1.x = cvt_pk_bf16(a1[0], a1[1]); w1.y = cvt_pk_bf16(a1[2], a1[3]);
                        *(u32x2*)rowp = w0; *(u32x2*)(rowp + 16) = w1;
                        asm volatile("" ::: "memory"); }
            } }
    }
};
struct EpiKvUp {
    static constexpr bool PERM = true, AFTER_DRAIN = false;
    bf16_t *K, *VT;
    __device__ __forceinline__ void operator()(const f32x4 (&acc)[2][2][4][2], const Unit& u, int wr, int wc, int fr, int fq) const {
        const int row0 = u.pm * BM + wr * 64 + fr;
        if (wc < 2) {
#pragma unroll
            for (int bj = 0; bj < 2; ++bj) { bf16_t* colp = K + (2 * u.pn + bj) * 96 + wc * 32 + 8 * fq;
#pragma unroll
                for (int ai = 0; ai < 2; ++ai)
#pragma unroll
                    for (int m = 0; m < 4; ++m) *(u32x4*)(colp + (size_t)(row0 + ai * HALF + m * 16) * 1536) = pack8(acc[ai][bj][m][0], acc[ai][bj][m][1]); }
        } else {
            const int b = row0 >> 11, s0 = row0 & 2047;
#pragma unroll
            for (int bj = 0; bj < 2; ++bj) { bf16_t* vp0 = VT + ((size_t)(b * 16 + 2 * u.pn + bj) * 64 + (wc - 2) * 32 + 8 * fq) * 2048 + s0;
#pragma unroll
                for (int n = 0; n < 2; ++n)
#pragma unroll
                    for (int e = 0; e < 4; ++e) { bf16_t* vp = vp0 + (size_t)(4 * n + e) * 2048;
#pragma unroll
                        for (int ai = 0; ai < 2; ++ai)
#pragma unroll
                            for (int m = 0; m < 4; ++m) vp[ai * HALF + m * 16] = (bf16_t)f2bf_rne(acc[ai][bj][m][n][e]); } }
        }
    }
};
struct MoeOrder {
    int t0, t1, ncol, G, c, bstride, pm_sub; const int* tile_e;
    __device__ __forceinline__ bool next(int i, Unit& u) const {
        const int L = i * G + c; if (L >= (t1 - t0) * ncol) return false;
        const int tile = t0 + L / ncol, pn = L % ncol;
        u.pm = tile - pm_sub; u.pn = tile_e[tile] * bstride + pn; return true;
    }
    __device__ __forceinline__ void a_ready(const Unit&) const {}
    __device__ __forceinline__ void done(const Unit&) const {}
};

template <class Epi, class Sched, bool ALIGN_EPI = false, bool SP2 = false>
__device__ __forceinline__ void gemm_phase(PG8_LAS unsigned char* lds, const Gemm g, const Sched& S, const Epi& E) {
    const int tid = threadIdx.x, wid = __builtin_amdgcn_readfirstlane(tid >> 6), lane = tid & 63, wr = wid >> 2, wc = wid & 3, fr = lane & 15, fq = lane >> 4;
    const int K = g.K, nt = K / BK;
    unsigned voffA[2], voffB[2];
#pragma unroll
    for (int i = 0; i < 2; ++i) { int R, C; stage_rc(tid * 16 + i * 8192, R, C); const int Rb = Epi::PERM ? ((R & ~31) + perm32(R & 31)) : R;
        voffA[i] = (unsigned)(R * K + C) * 2u; voffB[i] = (unsigned)(Rb * K + C) * 2u; }
    const size_t kstep = (size_t)(BK * 2);
    const size_t hstep = (size_t)HALF * K * 2;
    const size_t tstep = 2 * hstep;
    const unsigned ldsw = (unsigned)wid * 1024u;
    const int aoff = lds_byte(wr * 64 + fr, fq * 8), boff = lds_byte(wc * 32 + fr, fq * 8);
#define PG8_SA(b, h) (((b) * 2 + (h)) * HTB)
#define PG8_SB(b, h) ((4 + (b) * 2 + (h)) * HTB)
#define PG8_STAGE(bufoff, gbase, voff) do { _Pragma("unroll") for (int _i = 0; _i < 2; ++_i) \
        __builtin_amdgcn_global_load_lds((const unsigned*)((const char*)(gbase) + (voff)[_i]), (PG8_LAS unsigned*)(lds + (bufoff) + ldsw + _i * 8192), 16, 0, 0); } while (0)
#define PG8_LDA(dst, b, h) do { _Pragma("unroll") for (int m = 0; m < 4; ++m) _Pragma("unroll") for (int k = 0; k < 2; ++k) dst[m][k] = *(const PG8_LAS bf16x8*)(lds + PG8_SA(b, h) + aoff + m * 2048 + k * 1024); } while (0)
#define PG8_LDB(dst, b, h) do { _Pragma("unroll") for (int n = 0; n < 2; ++n) _Pragma("unroll") for (int k = 0; k < 2; ++k) dst[n][k] = *(const PG8_LAS bf16x8*)(lds + PG8_SB(b, h) + boff + n * 2048 + k * 1024); } while (0)
#define PG8_MMA(ai, bj, At, Bt) do { __builtin_amdgcn_s_setprio(1); _Pragma("unroll") for (int m = 0; m < 4; ++m) _Pragma("unroll") for (int n = 0; n < 2; ++n) _Pragma("unroll") for (int k = 0; k < 2; ++k) \
        acc[ai][bj][m][n] = __builtin_amdgcn_mfma_f32_16x16x32_bf16(Bt[n][k], At[m][k], acc[ai][bj][m][n], 0, 0, 0); __builtin_amdgcn_s_setprio(0); } while (0)
#define PG8_WAIT_V(n) asm volatile("s_waitcnt vmcnt(" #n ")" ::: "memory")
#define PG8_WAIT_L(n) asm volatile("s_waitcnt lgkmcnt(" #n ")" ::: "memory")
#define PG8_BAR __builtin_amdgcn_s_barrier()
#define PG8_SCHED __builtin_amdgcn_sched_barrier(0)
    Unit cur, nxt; int ui = 0;
    if (!S.next(0, cur)) return;
    f32x4 acc[2][2][4][2];
#pragma unroll
    for (int a = 0; a < 2; ++a)
#pragma unroll
        for (int b = 0; b < 2; ++b)
#pragma unroll
            for (int m = 0; m < 4; ++m)
#pragma unroll
                for (int n = 0; n < 2; ++n) acc[a][b][m][n] = (f32x4){0.f, 0.f, 0.f, 0.f};
    bf16x8 At[4][2], B0[2][2], B1[2][2];
    const char* cA = (const char*)g.A + (size_t)cur.pm * tstep; const char* cB = (const char*)g.Bt + (size_t)cur.pn * tstep;
    S.a_ready(cur);
    if constexpr (SP2) {
        PG8_STAGE(PG8_SB(0, 0), cB, voffB); PG8_STAGE(PG8_SB(0, 1), cB + hstep, voffB); PG8_STAGE(PG8_SA(0, 0), cA, voffA); PG8_STAGE(PG8_SA(0, 1), cA + hstep, voffA);
        if (wr == 1) PG8_BAR;
        PG8_WAIT_V(2); PG8_BAR;
        PG8_STAGE(PG8_SB(1, 0), cB + kstep, voffB); PG8_STAGE(PG8_SA(1, 0), cA + kstep, voffA); PG8_STAGE(PG8_SB(1, 1), cB + hstep + kstep, voffB);
        PG8_WAIT_V(6); PG8_BAR;
    } else {
        PG8_STAGE(PG8_SB(0, 0), cB, voffB); PG8_STAGE(PG8_SA(0, 0), cA, voffA); PG8_STAGE(PG8_SB(0, 1), cB + hstep, voffB); PG8_STAGE(PG8_SA(0, 1), cA + hstep, voffA);
        if (wr == 1) PG8_BAR;
        PG8_WAIT_V(4); PG8_BAR;
        PG8_STAGE(PG8_SB(1, 0), cB + kstep, voffB); PG8_STAGE(PG8_SA(1, 0), cA + kstep, voffA); PG8_STAGE(PG8_SB(1, 1), cB + hstep + kstep, voffB);
        PG8_WAIT_V(6); PG8_BAR;
    }
    for (;;) {
        const bool has_next = S.next(ui + 1, nxt);
        const char* nA = has_next ? (const char*)g.A + (size_t)nxt.pm * tstep : cA; const char* nB = has_next ? (const char*)g.Bt + (size_t)nxt.pn * tstep : cB;
        for (int t = 0; t < nt; t += 2) {
            const bool last = (t == nt - 2);
            const char* a1 = cA + (size_t)(t + 1) * kstep;
            const char* a2 = last ? nA : cA + (size_t)(t + 2) * kstep; const char* b2 = last ? nB : cB + (size_t)(t + 2) * kstep;
            const char* a3 = a2 + kstep; const char* b3 = b2 + kstep;
            if (last && has_next) S.a_ready(nxt);
            if constexpr (SP2) {
            PG8_LDB(B0, 0, 0); PG8_LDB(B1, 0, 1); PG8_SCHED; PG8_LDA(At, 0, 0); PG8_STAGE(PG8_SA(1, 1), a1 + hstep, voffA);
            PG8_WAIT_V(8); PG8_WAIT_L(0); PG8_BAR; PG8_MMA(0, 0, At, B0); PG8_MMA(0, 1, At, B1); PG8_BAR; PG8_SCHED;
            PG8_LDA(At, 0, 1); PG8_STAGE(PG8_SB(0, 0), b2, voffB); PG8_STAGE(PG8_SB(0, 1), b2 + hstep, voffB); PG8_STAGE(PG8_SA(0, 0), a2, voffA);
            PG8_WAIT_V(8); PG8_WAIT_L(0); PG8_BAR; PG8_MMA(1, 0, At, B0); PG8_MMA(1, 1, At, B1); PG8_BAR; PG8_SCHED;
            PG8_LDB(B0, 1, 0); PG8_LDB(B1, 1, 1); PG8_SCHED; PG8_LDA(At, 1, 0); PG8_STAGE(PG8_SA(0, 1), a2 + hstep, voffA);
            PG8_WAIT_V(8); PG8_WAIT_L(0); PG8_BAR; PG8_MMA(0, 0, At, B0); PG8_MMA(0, 1, At, B1); PG8_BAR; PG8_SCHED;
            PG8_LDA(At, 1, 1); PG8_STAGE(PG8_SB(1, 0), b3, voffB); PG8_STAGE(PG8_SB(1, 1), b3 + hstep, voffB); PG8_STAGE(PG8_SA(1, 0), a3, voffA);
            PG8_WAIT_V(8); PG8_WAIT_L(0); PG8_BAR; PG8_MMA(1, 0, At, B0); PG8_MMA(1, 1, At, B1); PG8_BAR; PG8_SCHED;
            } else {
            PG8_LDB(B0, 0, 0); PG8_SCHED; PG8_LDA(At, 0, 0); PG8_STAGE(PG8_SA(1, 1), a1 + hstep, voffA);
            PG8_WAIT_L(8); PG8_BAR; PG8_WAIT_L(0); PG8_MMA(0, 0, At, B0); PG8_BAR; PG8_SCHED;
            PG8_LDB(B1, 0, 1); PG8_STAGE(PG8_SB(0, 0), b2, voffB);
            PG8_BAR; PG8_WAIT_L(0); PG8_MMA(0, 1, At, B1); PG8_BAR;
            PG8_LDA(At, 0, 1); PG8_STAGE(PG8_SA(0, 0), a2, voffA);
            PG8_BAR; PG8_WAIT_L(0); PG8_MMA(1, 0, At, B0); PG8_BAR; PG8_SCHED;
            PG8_STAGE(PG8_SB(0, 1), b2 + hstep, voffB);
            PG8_WAIT_V(6); PG8_BAR; PG8_MMA(1, 1, At, B1); PG8_BAR;
            PG8_LDB(B0, 1, 0); PG8_SCHED; PG8_LDA(At, 1, 0); PG8_STAGE(PG8_SA(0, 1), a2 + hstep, voffA);
            PG8_WAIT_L(8); PG8_BAR; PG8_WAIT_L(0); PG8_MMA(0, 0, At, B0); PG8_BAR; PG8_SCHED;
            PG8_LDB(B1, 1, 1); PG8_STAGE(PG8_SB(1, 0), b3, voffB);
            PG8_BAR; PG8_WAIT_L(0); PG8_MMA(0, 1, At, B1); PG8_BAR;
            PG8_LDA(At, 1, 1); PG8_STAGE(PG8_SA(1, 0), a3, voffA);
            PG8_BAR; PG8_WAIT_L(0); PG8_MMA(1, 0, At, B0); PG8_BAR; PG8_SCHED;
            PG8_STAGE(PG8_SB(1, 1), b3 + hstep, voffB);
            PG8_WAIT_V(6); PG8_BAR; PG8_MMA(1, 1, At, B1); PG8_BAR;
            }
        }
        if constexpr (ALIGN_EPI) { if (wr == 0) PG8_BAR; }
        if constexpr (!Epi::AFTER_DRAIN) { E(acc, cur, wr, wc, fr, fq); S.done(cur); }
        if (!has_next) break;
#pragma unroll
        for (int a = 0; a < 2; ++a)
#pragma unroll
            for (int b = 0; b < 2; ++b)
#pragma unroll
                for (int m = 0; m < 4; ++m)
#pragma unroll
                    for (int n = 0; n < 2; ++n) acc[a][b][m][n] = (f32x4){0.f, 0.f, 0.f, 0.f};
        cur = nxt; cA = nA; cB = nB; ++ui;
        if constexpr (ALIGN_EPI) { if (wr == 1) PG8_BAR; }
    }
    PG8_WAIT_V(0);
    if constexpr (!ALIGN_EPI) { if (wr == 0) PG8_BAR; }
    PG8_BAR;
    if constexpr (Epi::AFTER_DRAIN) { E.fused(acc, cur, wr, wc, fr, fq, lds, wid, lane); S.done(cur); }
#undef PG8_SA
#undef PG8_SB
#undef PG8_STAGE
#undef PG8_LDA
#undef PG8_LDB
#undef PG8_MMA
#undef PG8_WAIT_V
#undef PG8_WAIT_L
#undef PG8_BAR
#undef PG8_SCHED
}
}

#define GAS __attribute__((address_space(1)))
#define LAS __attribute__((address_space(3)))
typedef unsigned short bf16;
typedef float f32x4 __attribute__((ext_vector_type(4)));
typedef float f32x2 __attribute__((ext_vector_type(2)));
typedef float f32x16 __attribute__((ext_vector_type(16)));
typedef short bf16x8 __attribute__((ext_vector_type(8)));
typedef unsigned u32x4 __attribute__((ext_vector_type(4)));
typedef unsigned u32x2 __attribute__((ext_vector_type(2)));
typedef __bf16 bf16x2_t __attribute__((ext_vector_type(2)));

constexpr int NWAVES = 8, NTHR = 512;
constexpr int NB = 8, SEQ = 2048, DM = 1024, MTOK = NB * SEQ;
constexpr int EIN_SRC = 3104, EIN_N = 3328, FF = 2816, FGU_N = 2 * FF, OIN_SRC = 416, OIN_N = 512, UQ_N = 1536, UKV_N = 2048, NEXP = 8;
constexpr int MAXT = 136, HALFT = 68;
constexpr float ALPHA = 1.4142135623730951f;
constexpr float LOG2E = 1.4426950408889634f;
constexpr float LAM_INIT = 0.2f;

constexpr size_t MiB = 1u << 20;
constexpr size_t WS_CTL = 0, CTL_ZERO_BYTES = 1 * MiB;
constexpr size_t WS_W_EIN = 1 * MiB, WS_W_EOUT = 8 * MiB, WS_W_FGU = 10 * MiB, WS_W_FDN = 21 * MiB, WS_W_OIN = 27 * MiB, WS_W_UQ = 28 * MiB, WS_W_UKV = 29 * MiB,
                 WS_W_OOUT = 30 * MiB, WS_W_MGU = 32 * MiB, WS_W_MDN = 120 * MiB;
constexpr size_t WS_TAB = 164 * MiB;
constexpr size_t WS_ROPE = WS_TAB, WS_LUT = WS_TAB + 256 * 1024, WS_TOKE = WS_TAB + 512 * 1024, WS_TOKW = WS_TAB + 640 * 1024, WS_POS = WS_TAB + 768 * 1024,
                 WS_BLKCNT = WS_TAB + 896 * 1024, WS_TILEE = WS_TAB + 960 * 1024;
constexpr size_t WS_XB = 166 * MiB;
constexpr size_t WS_QG = 198 * MiB, WS_KG = 206 * MiB, WS_VG = 214 * MiB, WS_GG = 230 * MiB, WS_QD = 246 * MiB, WS_KD = 262 * MiB, WS_VDT = 278 * MiB, WS_ALR = 294 * MiB,
                 WS_OB = 296 * MiB, WS_AO = 328 * MiB, WS_OF = WS_XB;
constexpr size_t WS_H = 198 * MiB;
constexpr size_t WS_CQ = 198 * MiB, WS_CKV = 214 * MiB, WS_KR = 222 * MiB, WS_CQN = 224 * MiB, WS_CKVN = 232 * MiB, WS_Q = 236 * MiB, WS_K = 284 * MiB, WS_VT = 332 * MiB, WS_AO2 = 198 * MiB;
constexpr size_t WS_XP = 198 * MiB, WS_HP = 266 * MiB;
constexpr size_t WS_END = 364 * MiB;
static_assert(WS_HP + (size_t)HALFT * 256 * FF * 2 <= WS_END && WS_XP + (size_t)MAXT * 256 * DM * 2 <= WS_HP, "moe map");
constexpr int CW_BAR = 4096;
constexpr int RING_BYTES = 131072, LDSCTL_OFF = RING_BYTES, MISC_OFF = LDSCTL_OFF + 320, LDS_BYTES = 147456;

#define RLX_AGENT __ATOMIC_RELAXED, __HIP_MEMORY_SCOPE_AGENT
#define LDS_WAIT() asm volatile("s_waitcnt lgkmcnt(0)" ::: "memory")
__device__ __forceinline__ unsigned f2bf(float f) { unsigned u = __builtin_bit_cast(unsigned, f); return (u + 0x7fffu + ((u >> 16) & 1u)) >> 16; }
__device__ __forceinline__ unsigned pk2(float lo, float hi) { return f2bf(lo) | (f2bf(hi) << 16); }
__device__ __forceinline__ float bf2f(unsigned short b) { return __builtin_bit_cast(float, (unsigned)b << 16); }
__device__ __forceinline__ unsigned cvtpk(float lo, float hi) { f32x2 v = {lo, hi}; bf16x2_t b = __builtin_convertvector(v, bf16x2_t); return __builtin_bit_cast(unsigned, b); }
__device__ __forceinline__ float wave_sum(float v) {
#pragma unroll
    for (int o = 1; o < 64; o <<= 1) v += __shfl_xor(v, o);
    return v;
}

#define XB_TMO      128
#define XB_XCNT(j)  (256  + 64 * (j))
#define XB_XSUB(j)  (1280 + 64 * (j))
#define XB_XGEN(j)  (2304 + 64 * (j))
#define XB_TOP      3328
#define XB_TOPGEN   3392
#define XCD_BAR_WORDS 3456
#define XB_SPIN_CAP (1u << 18)
__device__ __forceinline__ unsigned xb_ld(unsigned* p)              { return __hip_atomic_load(p, __ATOMIC_RELAXED, __HIP_MEMORY_SCOPE_AGENT); }
__device__ __forceinline__ unsigned xb_add(unsigned* p, unsigned v) { return __hip_atomic_fetch_add(p, v, __ATOMIC_RELAXED, __HIP_MEMORY_SCOPE_AGENT); }
__device__ __forceinline__ unsigned xb_xcc_id() { return (unsigned)__builtin_amdgcn_s_getreg((3 << 11) | 20) & 0xFu; }
#define XB_SPIN(cond, bar) do { unsigned _sp = 0; while (cond) { __builtin_amdgcn_s_sleep(1); \
    if ((++_sp & 255u) == 0u) { if (xb_ld(&(bar)[XB_TMO])) break; if (_sp > XB_SPIN_CAP) { atomicAdd(&(bar)[XB_TMO], 1u); break; } } } } while (0)
struct XcdBarrier { unsigned* bar; unsigned x; volatile LAS unsigned* st; };
__device__ __forceinline__ XcdBarrier xcd_barrier_post(unsigned* bar, volatile LAS unsigned* st) {
    XcdBarrier b; b.bar = bar; b.x = xb_xcc_id(); b.st = st;
    if (threadIdx.x == 0) (void)xb_add(&bar[XB_XCNT(b.x)], 1u);
    return b;
}
__device__ __forceinline__ void xcd_barrier_complete(unsigned* bar, unsigned x, unsigned& nloc, unsigned& nx) {
    const unsigned G = gridDim.x * gridDim.y * gridDim.z;
    unsigned sum, cnt, mine, sp = 0u;
    for (;;) {
        sum = 0u; cnt = 0u; mine = 0u;
#pragma unroll
        for (unsigned j = 0; j < 16; ++j) { const unsigned c = xb_ld(&bar[XB_XCNT(j)]); sum += c; cnt += (c > 0u) ? 1u : 0u; mine = (j == x) ? c : mine; }
        if (sum == G) break;
        __builtin_amdgcn_s_sleep(1);
        if ((++sp & 255u) == 0u) { if (xb_ld(&bar[XB_TMO])) break; if (sp > XB_SPIN_CAP) { atomicAdd(&bar[XB_TMO], 1u); break; } }
    }
    nloc = mine > 0u ? mine : 1u; nx = cnt > 0u ? cnt : 1u;
}
__device__ __forceinline__ void xcd_barrier(const XcdBarrier& b) {
    asm volatile("s_waitcnt vmcnt(0)" ::: "memory");
    __syncthreads();
    if (threadIdx.x == 0) {
        unsigned* bar = b.bar;
        __builtin_amdgcn_s_waitcnt(0);
        unsigned nloc = b.st[0], nx = b.st[1];
        if (nloc == 0u) { xcd_barrier_complete(bar, b.x, nloc, nx); b.st[0] = nloc; b.st[1] = nx; }
        const unsigned old = xb_add(&bar[XB_XSUB(b.x)], 1u);
        const unsigned gen = old / nloc;
        if (old + 1u == (gen + 1u) * nloc) {
            __builtin_amdgcn_fence(__ATOMIC_RELEASE, "agent");
            asm volatile("s_waitcnt vmcnt(0)" ::: "memory");
            const unsigned og = xb_add(&bar[XB_TOP], 1u);
            const unsigned tg = og / nx;
            if (og + 1u == (tg + 1u) * nx) xb_add(&bar[XB_TOPGEN], 1u);
            else XB_SPIN(xb_ld(&bar[XB_TOPGEN]) == tg, bar);
            __builtin_amdgcn_fence(__ATOMIC_ACQUIRE, "agent");
            xb_add(&bar[XB_XGEN(b.x)], 1u);
            asm volatile("s_waitcnt vmcnt(0)" ::: "memory");
        } else {
            XB_SPIN(xb_ld(&bar[XB_XGEN(b.x)]) == gen, bar);
            __builtin_amdgcn_fence(__ATOMIC_ACQUIRE, "agent");
            asm volatile("s_waitcnt vmcnt(0)" ::: "memory");
        }
    }
    __syncthreads();
}

__device__ __forceinline__ void tr_item(const float* W, int K, int N, bf16* WT, int dstrow0, LAS float* scr, int kb, int n0, int lane) {
    const int k0 = 64 * kb;
#pragma unroll 8
    for (int i = 0; i < 32; ++i) { const int kk = 2 * i + (lane >> 5); scr[kk * 33 + (lane & 31)] = W[(size_t)(k0 + kk) * N + n0 + (lane & 31)]; }
    LDS_WAIT(); asm volatile("" ::: "memory");
    const int c = lane & 7;
#pragma unroll
    for (int j = 0; j < 4; ++j) { const int n = (lane >> 3) + 8 * j; const LAS float* s = scr + (8 * c) * 33 + n;
        u32x4 o; o.x = pk2(s[0 * 33], s[1 * 33]); o.y = pk2(s[2 * 33], s[3 * 33]); o.z = pk2(s[4 * 33], s[5 * 33]); o.w = pk2(s[6 * 33], s[7 * 33]);
        *(GAS u32x4*)(WT + (size_t)(dstrow0 + n) * K + k0 + 8 * c) = o; }
    LDS_WAIT(); asm volatile("" ::: "memory");
}
template <int MODE>
__device__ __forceinline__ void tr_matrix(const float* W, int K, int N, bf16* WT, int row_off, LAS float* scr, int gw, int NGW, int lane) {
    const int nblk = N / 32, nitems = (K / 64) * nblk;
    for (int it = gw; it < nitems; it += NGW) { const int kb = it / nblk, n0 = 32 * (it % nblk); int d;
        if (MODE == 0) d = n0;
        else if (MODE == 1) d = (n0 < 1536) ? n0 : (n0 == 1536 ? 3072 : n0 - 32);
        else d = 256 * (n0 >> 7) + (n0 & 127) + (MODE == 3 ? 128 : 0);
        tr_item(W, K, N, WT, row_off + d, scr, kb, n0, lane); }
}
__device__ __forceinline__ void row_to_bf16(const float* xrow, bf16* orow, int lane) {
    const GAS f32x4* xr = (const GAS f32x4*)xrow + lane; GAS unsigned long long* o8 = (GAS unsigned long long*)orow + lane;
#pragma unroll
    for (int j = 0; j < 4; ++j) { const f32x4 v = xr[64 * j]; o8[64 * j] = (unsigned long long)pk2(v.x, v.y) | ((unsigned long long)pk2(v.z, v.w) << 32); }
}
__device__ __forceinline__ void ln_apply(f32x4 (&v)[4], const float* g, const float* b, int lane) {
    float s = 0.f;
#pragma unroll
    for (int j = 0; j < 4; ++j) s += (v[j].x + v[j].y) + (v[j].z + v[j].w);
    const float mean = wave_sum(s) * (1.f / DM); float s2 = 0.f;
#pragma unroll
    for (int j = 0; j < 4; ++j) { v[j] = v[j] - mean; s2 += (v[j].x * v[j].x + v[j].y * v[j].y) + (v[j].z * v[j].z + v[j].w * v[j].w); }
    const float rstd = 1.f / sqrtf(wave_sum(s2) * (1.f / DM) + 1e-5f);
#pragma unroll
    for (int j = 0; j < 4; ++j) { const f32x4 gg = *((const f32x4*)g + lane + 64 * j), bb = *((const f32x4*)b + lane + 64 * j); v[j] = v[j] * rstd * gg + bb; }
}
__device__ __forceinline__ void store_row_f32_bf16(const f32x4 (&v)[4], float* frow, bf16* brow, int lane) {
    GAS f32x4* fr = (GAS f32x4*)frow + lane; GAS unsigned long long* o8 = (GAS unsigned long long*)brow + lane;
#pragma unroll
    for (int j = 0; j < 4; ++j) { fr[64 * j] = v[j]; o8[64 * j] = (unsigned long long)pk2(v[j].x, v[j].y) | ((unsigned long long)pk2(v[j].z, v[j].w) << 32); }
}

struct AttnP {
    const bf16* Q; const bf16* K; const bf16* VT; bf16* O;
    const float* lut;
    const float* dlam;
    const float* dgain;
};
template <bool DIFF>
__device__ __forceinline__ void attn_phase(LAS unsigned char* lds, const AttnP& P, int G, int c) {
    constexpr int KW = DIFF ? 128 : 96, DQ = DIFF ? 64 : 96, DV = DIFF ? 128 : 64, NH = DIFF ? 4 : 16;
    constexpr int LDQ = DIFF ? 512 : 1536, LDK = DIFF ? 512 : 1536, HQ = DIFF ? 128 : 96;
    constexpr int KPITCH = KW * 2 + 16, VPITCH = 144, KBYTES = 64 * KPITCH, VBYTES = DV * VPITCH, STAGE = KBYTES + VBYTES;
    constexpr int NDS = DQ / 16, NRB = DV / 32, KPR = KW / 8, NKPIECE = 64 * KPR, NVPIECE = DV * 8;
    constexpr int NKI = (NKPIECE + NTHR - 1) / NTHR, NVI = (NVPIECE + NTHR - 1) / NTHR;
    constexpr int QROWS = DIFF ? 128 : 256, NQB = SEQ / QROWS, NUNITS = NB * NH * NQB;
    constexpr int LUT_OFF = 2 * STAGE;
    static_assert(LUT_OFF + (DIFF ? 8192 : 0) <= RING_BYTES && 2 * STAGE >= (DIFF ? 65536 : 0), "attn lds");
    const int tid = threadIdx.x, lane = tid & 63, wid = __builtin_amdgcn_readfirstlane(tid >> 6), r = lane & 31, h2 = lane >> 5;
    const int pir = (r & ~12) | ((r & 4) << 1) | ((r & 8) >> 1);
    float lam = 0.f;
    if (DIFF) {
        LAS float* L = (LAS float*)(lds + LUT_OFF);
        for (int i = tid; i < 4 * 512; i += NTHR) L[i] = P.lut[i];
        const float a = P.dlam[lane] * P.dlam[64 + lane], b2 = P.dlam[128 + lane] * P.dlam[192 + lane];
        lam = __expf(wave_sum(a)) - __expf(wave_sum(b2)) + LAM_INIT;
        __syncthreads();
    }
    for (int unit = c; unit < NUNITS; unit += G) {
        int b, h, q0, map;
        if (DIFF) { const int qb = unit & 15; h = (unit >> 4) & 3; b = unit >> 6; map = wid >> 2; q0 = qb * 128 + 32 * (wid & 3); }
        else { const int qb = unit & 7; h = (unit >> 3) & 15; b = unit >> 7; map = 0; q0 = qb * 256 + 32 * wid; }
        const size_t tok0 = (size_t)b * SEQ;
        bf16x8 qf[NDS];
        { const bf16* qp = P.Q + (tok0 + q0 + r) * LDQ + h * HQ + map * 64 + 8 * h2;
#pragma unroll
          for (int ds = 0; ds < NDS; ++ds) qf[ds] = *(const bf16x8*)(qp + 16 * ds); }
        const bf16* Kb = P.K + tok0 * LDK + h * HQ;
        const bf16* Vb = P.VT + (size_t)(b * NH + h) * DV * SEQ;
        u32x4 kst[NKI], vst[NVI];
#define ATT_LOAD(t) do { \
        _Pragma("unroll") for (int i = 0; i < NKI; ++i) { const int p = tid + i * NTHR; if (NKPIECE % NTHR == 0 || p < NKPIECE) { const int row = p / KPR, cp = p % KPR; kst[i] = *(const u32x4*)(Kb + (size_t)(64 * (t) + row) * LDK + 8 * cp); } } \
        _Pragma("unroll") for (int i = 0; i < NVI; ++i) { const int p = tid + i * NTHR; const int row = p >> 3, cp = p & 7; vst[i] = *(const u32x4*)(Vb + (size_t)row * SEQ + 64 * (t) + 8 * cp); } } while (0)
#define ATT_STORE(buf) do { \
        _Pragma("unroll") for (int i = 0; i < NKI; ++i) { const int p = tid + i * NTHR; if (NKPIECE % NTHR == 0 || p < NKPIECE) { const int row = p / KPR, cp = p % KPR; *(LAS u32x4*)(lds + (buf) * STAGE + row * KPITCH + 16 * cp) = kst[i]; } } \
        _Pragma("unroll") for (int i = 0; i < NVI; ++i) { const int p = tid + i * NTHR; const int row = p >> 3, cp = p & 7; *(LAS u32x4*)(lds + (buf) * STAGE + KBYTES + row * VPITCH + 16 * cp) = vst[i]; } } while (0)
        f32x16 O[NRB];
#pragma unroll
        for (int rb = 0; rb < NRB; ++rb)
#pragma unroll
            for (int i = 0; i < 16; ++i) O[rb][i] = 0.f;
        float mrun = -1e30f, lrun = 0.f;
        ATT_LOAD(0); ATT_STORE(0); __syncthreads();
        const int koff = pir * KPITCH + (map * 64 + 8 * h2) * 2, voff = KBYTES + r * VPITCH + 16 * h2;
        const int qpos = q0 + r, qlo = q0, qhi = q0 + 31;
        for (int t = 0; t < SEQ / 64; ++t) {
            const int buf = t & 1;
            if (t + 1 < SEQ / 64) ATT_LOAD(t + 1);
            const LAS unsigned char* kb = lds + buf * STAGE + koff; const LAS unsigned char* vb = lds + buf * STAGE + voff;
            f32x16 st[2];
#pragma unroll
            for (int kg = 0; kg < 2; ++kg) {
#pragma unroll
                for (int i = 0; i < 16; ++i) st[kg][i] = 0.f;
#pragma unroll
                for (int ds = 0; ds < NDS; ++ds) { const bf16x8 kf = *(const LAS bf16x8*)(kb + kg * 32 * KPITCH + ds * 32); st[kg] = __builtin_amdgcn_mfma_f32_32x32x16_bf16(kf, qf[ds], st[kg], 0, 0, 0); }
            }
            if (DIFF) {
                const LAS float* L = (const LAS float*)(lds + LUT_OFF) + h * 512;
                const int k0 = 64 * t;
                if (k0 - qhi >= 91) { const float cb = L[256 + 100];
#pragma unroll
                    for (int kg = 0; kg < 2; ++kg)
#pragma unroll
                        for (int i = 0; i < 16; ++i) st[kg][i] += cb;
                } else if (qlo - (k0 + 63) >= 91) { const float cb = L[256 - 100];
#pragma unroll
                    for (int kg = 0; kg < 2; ++kg)
#pragma unroll
                        for (int i = 0; i < 16; ++i) st[kg][i] += cb;
                } else {
                    const int base = k0 + 8 * h2 - qpos + 256;
#pragma unroll
                    for (int kg = 0; kg < 2; ++kg)
#pragma unroll
                        for (int i = 0; i < 16; ++i) st[kg][i] += L[base + 32 * kg + 16 * (i >> 3) + (i & 7)];
                }
            }
            float mx = st[0][0];
#pragma unroll
            for (int i = 1; i < 16; ++i) mx = fmaxf(mx, st[0][i]);
#pragma unroll
            for (int i = 0; i < 16; ++i) mx = fmaxf(mx, st[1][i]);
            mx = fmaxf(mx, __shfl_xor(mx, 32));
            const float mnew = fmaxf(mrun, mx); const float alpha = __builtin_amdgcn_exp2f(mrun - mnew); mrun = mnew;
            float rs = 0.f;
#pragma unroll
            for (int kg = 0; kg < 2; ++kg)
#pragma unroll
                for (int i = 0; i < 16; ++i) { const float p = __builtin_amdgcn_exp2f(st[kg][i] - mnew); st[kg][i] = p; rs += p; }
            lrun = lrun * alpha + rs;
#pragma unroll
            for (int rb = 0; rb < NRB; ++rb)
#pragma unroll
                for (int i = 0; i < 16; ++i) O[rb][i] *= alpha;
            bf16x8 pf[2][2];
#pragma unroll
            for (int kg = 0; kg < 2; ++kg)
#pragma unroll
                for (int s2 = 0; s2 < 2; ++s2) { u32x4 w; w.x = cvtpk(st[kg][8 * s2 + 0], st[kg][8 * s2 + 1]); w.y = cvtpk(st[kg][8 * s2 + 2], st[kg][8 * s2 + 3]);
                    w.z = cvtpk(st[kg][8 * s2 + 4], st[kg][8 * s2 + 5]); w.w = cvtpk(st[kg][8 * s2 + 6], st[kg][8 * s2 + 7]); pf[kg][s2] = __builtin_bit_cast(bf16x8, w); }
#pragma unroll
            for (int rb = 0; rb < NRB; ++rb) {
#pragma unroll
                for (int kg = 0; kg < 2; ++kg)
#pragma unroll
                    for (int s2 = 0; s2 < 2; ++s2) { const bf16x8 vf = *(const LAS bf16x8*)(vb + rb * 32 * VPITCH + (32 * kg + 16 * s2) * 2); O[rb] = __builtin_amdgcn_mfma_f32_32x32x16_bf16(vf, pf[kg][s2], O[rb], 0, 0, 0); }
                __builtin_amdgcn_sched_barrier(0); }
            if (t + 1 < SEQ / 64) ATT_STORE(buf ^ 1);
            __syncthreads();
        }
        const float ltot = lrun + __shfl_xor(lrun, 32); const float inv = 1.0f / ltot;
        int lane_e = lane; asm volatile("" : "+v"(lane_e));
        const int r_e = lane_e & 31, h2_e = lane_e >> 5;
        if (!DIFF) {
            bf16* op = P.O + (tok0 + q0 + r_e) * DM + h * 64 + 4 * h2_e;
#pragma unroll
            for (int rb = 0; rb < NRB; ++rb)
#pragma unroll
                for (int g = 0; g < 4; ++g) { u32x2 w; w.x = cvtpk(O[rb][4 * g] * inv, O[rb][4 * g + 1] * inv); w.y = cvtpk(O[rb][4 * g + 2] * inv, O[rb][4 * g + 3] * inv); *(u32x2*)(op + 32 * rb + 8 * g) = w; }
        } else {
            LAS float* X = (LAS float*)lds;
            if (map == 1) { const float sc = inv * lam;
#pragma unroll
                for (int rb = 0; rb < NRB; ++rb)
#pragma unroll
                    for (int i = 0; i < 16; ++i) X[((wid - 4) * 64 + rb * 16 + i) * 64 + lane_e] = O[rb][i] * sc; }
            __syncthreads();
            if (map == 0) { float ss = 0.f;
#pragma unroll
                for (int rb = 0; rb < NRB; ++rb)
#pragma unroll
                    for (int i = 0; i < 16; ++i) { const float o = O[rb][i] * inv - X[(wid * 64 + rb * 16 + i) * 64 + lane_e]; O[rb][i] = o; ss += o * o; }
                ss += __shfl_xor(ss, 32);
                const float rn = (1.0f - LAM_INIT) / sqrtf(ss * (1.0f / 128.0f) + 1e-6f);
                bf16* op = P.O + (tok0 + q0 + r_e) * DM + 512 + h * 128 + 4 * h2_e;
#pragma unroll
                for (int rb = 0; rb < NRB; ++rb)
#pragma unroll
                    for (int g = 0; g < 4; ++g) { const f32x4 gn = *(const f32x4*)(P.dgain + 32 * rb + 8 * g + 4 * h2_e);
                        u32x2 w; w.x = cvtpk(O[rb][4 * g] * rn * gn[0], O[rb][4 * g + 1] * rn * gn[1]); w.y = cvtpk(O[rb][4 * g + 2] * rn * gn[2], O[rb][4 * g + 3] * rn * gn[3]); *(u32x2*)(op + 32 * rb + 8 * g) = w; }
            }
            __syncthreads();
        }
#undef ATT_LOAD
#undef ATT_STORE
    }
}

struct GlaP { const bf16 *QG, *KG, *VG; const float* ALR; const float* gate_up; const float* gate_bias; float* OF; float* OB; };
__device__ __forceinline__ void gla_unit(LAS unsigned char* lds, const GlaP& P, int unit) {
    const int tid = threadIdx.x, lane = tid & 63, wid = __builtin_amdgcn_readfirstlane(tid >> 6);
    const int b = unit >> 3, h = (unit >> 1) & 3, dir = unit & 1;
    LAS float* A = (LAS float*)lds;
    LAS float* Kk = A + 4096;
    LAS float* Qq = Kk + 4096;
    LAS float* Vv = Qq + 4096;
    LAS float* GU = Vv + 8192;
    LAS float* GB = GU + 1024;
    LAS float* AL = GB + 64;
    const int j = 16 * wid + (lane & 15), qd = lane >> 4;
    float S[16];
#pragma unroll
    for (int i = 0; i < 16; ++i) S[i] = 0.f;
    for (int i = tid; i < 1024; i += NTHR) { const int rr = i >> 6, ii = i & 63; GU[i] = P.gate_up[(size_t)(dir * 16 + rr) * 256 + h * 64 + ii]; }
    if (tid < 64) GB[tid] = P.gate_bias[dir * 256 + h * 64 + tid];
    float* OUT = dir ? P.OB : P.OF;
    const size_t tok0 = (size_t)b * SEQ;
    for (int c = 0; c < SEQ / 64; ++c) {
        const int tb = dir ? (SEQ - 64 * (c + 1)) : 64 * c;
        __syncthreads();
        for (int i = tid; i < 4096; i += NTHR) { const int s = i >> 6, ii = i & 63; const size_t tk = tok0 + tb + s;
            Kk[i] = bf2f(P.KG[tk * 256 + h * 64 + ii]); Qq[i] = bf2f(P.QG[tk * 256 + h * 64 + ii]); }
        for (int i = tid; i < 8192; i += NTHR) { const int s = i >> 7, jj = i & 127; Vv[i] = bf2f(P.VG[(tok0 + tb + s) * 512 + h * 128 + jj]); }
        for (int i = tid; i < 1024; i += NTHR) { const int s = i >> 4, rr = i & 15; AL[i] = P.ALR[(tok0 + tb + s) * 32 + dir * 16 + rr]; }
        __syncthreads();
        for (int i = tid; i < 4096; i += NTHR) { const int s = i >> 6, ii = i & 63; float x = GB[ii];
#pragma unroll
            for (int rr = 0; rr < 16; ++rr) x += AL[s * 16 + rr] * GU[rr * 64 + ii];
            const float ls = fminf(x, 0.f) - log1pf(__expf(-fabsf(x)));
            A[i] = __expf(ls * (1.0f / 16.0f)); }
        __syncthreads();
        for (int step = 0; step < 64; ++step) {
            const int s = dir ? 63 - step : step;
            const float v = Vv[s * 128 + j]; float o = 0.f;
            const LAS f32x4* a4 = (const LAS f32x4*)(A + s * 64 + 16 * qd); const LAS f32x4* k4 = (const LAS f32x4*)(Kk + s * 64 + 16 * qd); const LAS f32x4* q4 = (const LAS f32x4*)(Qq + s * 64 + 16 * qd);
#pragma unroll
            for (int g = 0; g < 4; ++g) { const f32x4 aa = a4[g], kk = k4[g], qq = q4[g];
#pragma unroll
                for (int e = 0; e < 4; ++e) { const float sn = aa[e] * S[4 * g + e] + kk[e] * v; S[4 * g + e] = sn; o += qq[e] * sn; } }
            o += __shfl_xor(o, 16); o += __shfl_xor(o, 32);
            if (qd == 0) OUT[(tok0 + tb + s) * 512 + h * 128 + j] = o;
        }
    }
    __syncthreads();
}

#ifndef MK_PER_PHASE
#define MK_PER_PHASE 1
#endif
constexpr int NPHASE = 21;
struct Args { const float* in[24]; float* out; unsigned char* ws; int ph_lo, ph_hi; };
static_assert(sizeof(Args) == 24 * 8 + 8 + 8 + 8, "Args has no padding");
enum { I_X = 0, I_RELB, I_EWIN, I_GUP, I_GBIAS, I_GLAGAIN, I_DLAM, I_DGAIN, I_EWOUT, I_FG, I_FU, I_FD, I_OWIN, I_QGAIN, I_KVGAIN, I_WUQ, I_WUKV, I_OWOUT, I_ROUTER, I_MG, I_MU, I_MD, I_LNG, I_LNB };

__global__ void __launch_bounds__(NTHR, 2) mega_fwd(Args args) {
    extern __shared__ __attribute__((aligned(16))) unsigned char lds_raw[];
    LAS unsigned char* lds = (LAS unsigned char*)lds_raw;
    volatile LAS unsigned* MISC = (volatile LAS unsigned*)(lds + MISC_OFF);
    const int tid = threadIdx.x, lane = tid & 63, wave = __builtin_amdgcn_readfirstlane(tid >> 6);
    const int G = gridDim.x, bx = blockIdx.x;
    const int vcu = (G % 8 == 0) ? (bx % 8) * (G / 8) + bx / 8 : bx;
    const int gw = vcu * NWAVES + wave, NGW = G * NWAVES;
    unsigned char* ws = args.ws;
    for (int u = tid; u < (LDS_BYTES - LDSCTL_OFF) / 4; u += NTHR) ((LAS unsigned*)(lds + LDSCTL_OFF))[u] = 0u;
    __syncthreads();
    const int lo = args.ph_lo, hi = args.ph_hi;
    XcdBarrier bar; bar.bar = (unsigned*)(ws + WS_CTL) + CW_BAR; bar.x = 0; bar.st = nullptr;
    if (hi - lo > 1) bar = xcd_barrier_post((unsigned*)(ws + WS_CTL) + CW_BAR, MISC + 8);
#ifdef ONLY_PHASE
#define IN(k) ((k) == ONLY_PHASE && lo <= (k) && (k) < hi)
#else
#define IN(k) (lo <= (k) && (k) < hi)
#endif
#define SEAM(k) do { if (IN(k) && IN((k) + 1)) xcd_barrier(bar); } while (0)

    const float* x_in = args.in[I_X];
    const float* ln_g = args.in[I_LNG]; const float* ln_b = args.in[I_LNB];
    float* XF = args.out;
    bf16* W_EIN = (bf16*)(ws + WS_W_EIN); bf16* W_EOUT = (bf16*)(ws + WS_W_EOUT); bf16* W_FGU = (bf16*)(ws + WS_W_FGU); bf16* W_FDN = (bf16*)(ws + WS_W_FDN);
    bf16* W_OIN = (bf16*)(ws + WS_W_OIN); bf16* W_UQ = (bf16*)(ws + WS_W_UQ); bf16* W_UKV = (bf16*)(ws + WS_W_UKV); bf16* W_OOUT = (bf16*)(ws + WS_W_OOUT);
    bf16* W_MGU = (bf16*)(ws + WS_W_MGU); bf16* W_MDN = (bf16*)(ws + WS_W_MDN);
    float* ROPE = (float*)(ws + WS_ROPE); float* LUT = (float*)(ws + WS_LUT);
    int* TOKE = (int*)(ws + WS_TOKE); float* TOKW = (float*)(ws + WS_TOKW); int* POS = (int*)(ws + WS_POS); int* BLKCNT = (int*)(ws + WS_BLKCNT); int* TILEE = (int*)(ws + WS_TILEE);
    bf16* XB = (bf16*)(ws + WS_XB);
    bf16* QG = (bf16*)(ws + WS_QG); bf16* KG = (bf16*)(ws + WS_KG); bf16* VG = (bf16*)(ws + WS_VG); bf16* GG = (bf16*)(ws + WS_GG);
    bf16* QD = (bf16*)(ws + WS_QD); bf16* KD = (bf16*)(ws + WS_KD); bf16* VDT = (bf16*)(ws + WS_VDT); float* ALR = (float*)(ws + WS_ALR);
    float* OFb = (float*)(ws + WS_OF); float* OBb = (float*)(ws + WS_OB); bf16* AO = (bf16*)(ws + WS_AO);
    bf16* Hb = (bf16*)(ws + WS_H);
    float* CQ = (float*)(ws + WS_CQ); float* CKV = (float*)(ws + WS_CKV); float* KR = (float*)(ws + WS_KR); bf16* CQN = (bf16*)(ws + WS_CQN); bf16* CKVN = (bf16*)(ws + WS_CKVN);
    bf16* Qb = (bf16*)(ws + WS_Q); bf16* Kb = (bf16*)(ws + WS_K); bf16* VTb = (bf16*)(ws + WS_VT); bf16* AO2 = (bf16*)(ws + WS_AO2);
    bf16* XP = (bf16*)(ws + WS_XP); bf16* HP = (bf16*)(ws + WS_HP);

    if (IN(0)) {
        LAS float* scr = (LAS float*)(lds + wave * 16384);
        int off = 0;
#define TRM(MODE, W, K, N, WT, ROFF) do { const int nit_ = ((K) / 64) * ((N) / 32); int g0_ = (gw - off) % NGW; if (g0_ < 0) g0_ += NGW; tr_matrix<MODE>((W), (K), (N), (WT), (ROFF), scr, g0_, NGW, lane); off = (off + nit_) % NGW; } while (0)
        TRM(1, args.in[I_EWIN], 1024, EIN_SRC, W_EIN, 0);
        TRM(0, args.in[I_EWOUT], 1024, 1024, W_EOUT, 0);
        TRM(2, args.in[I_FG], 1024, FF, W_FGU, 0);
        TRM(3, args.in[I_FU], 1024, FF, W_FGU, 0);
        TRM(0, args.in[I_FD], FF, 1024, W_FDN, 0);
        TRM(0, args.in[I_OWIN], 1024, OIN_SRC, W_OIN, 0);
        TRM(0, args.in[I_WUQ], 256, UQ_N, W_UQ, 0);
        TRM(0, args.in[I_WUKV], 128, UKV_N, W_UKV, 0);
        TRM(0, args.in[I_OWOUT], 1024, 1024, W_OOUT, 0);
        for (int e = 0; e < NEXP; ++e) {
            TRM(2, args.in[I_MG] + (size_t)e * 1024 * FF, 1024, FF, W_MGU, e * FGU_N);
            TRM(3, args.in[I_MU] + (size_t)e * 1024 * FF, 1024, FF, W_MGU, e * FGU_N);
            TRM(0, args.in[I_MD] + (size_t)e * FF * 1024, FF, 1024, W_MDN, e * 1024);
        }
#undef TRM
        for (int m = gw; m < MTOK; m += NGW) row_to_bf16(x_in + (size_t)m * DM, XB + (size_t)m * DM, lane);
        const int gt = bx * NTHR + tid, NGT = G * NTHR;
        for (int i = gt; i < SEQ * 16; i += NGT) { const int pos = i >> 4, k = i & 15; const float inv = (float)pow(10000.0, -(double)k / 16.0); const float ang = (float)pos * inv;
            ROPE[2 * i] = (float)cos((double)ang); ROPE[2 * i + 1] = (float)sin((double)ang); }
        for (int i = gt; i < 4 * 512; i += NGT) { const int h = i >> 9, rel = (i & 511) - 256; const int n = rel < 0 ? -rel : rel; int bk = rel > 0 ? 16 : 0;
            int nl = n; if (n >= 8) { nl = 8 + (31 - __clz(n * n)) - 6; if (nl > 15) nl = 15; }
            bk += nl; LUT[i] = args.in[I_RELB][bk * 4 + h] * LOG2E; }
    }
    SEAM(0);
    if (IN(1)) {
        pg8::Gemm g{XB, W_EIN, MTOK, EIN_N, DM}; pg8::StaticOrder S; S.init(MTOK, EIN_N, G, bx);
        pg8::EpiEvenIn E{QG, KG, VG, GG, QD, KD, VDT, ALR};
        pg8::gemm_phase<pg8::EpiEvenIn, pg8::StaticOrder, true, true>(lds, g, S, E);
    }
    SEAM(1);
    if (IN(2)) {
        const GlaP GP{QG, KG, VG, ALR, args.in[I_GUP], args.in[I_GBIAS], OFb, OBb};
#ifndef SKIP_GLA
        for (int u = bx; u < 64; u += G) gla_unit(lds, GP, u);
#endif
        __syncthreads();
        const AttnP AP{QD, KD, VDT, AO, LUT, args.in[I_DLAM], args.in[I_DGAIN]};
#ifndef SKIP_DIFF
        attn_phase<true>(lds, AP, G, bx);
#endif
    }
    SEAM(2);
    if (IN(3)) {
        const float* ggain = args.in[I_GLAGAIN];
        for (int m = gw; m < MTOK; m += NGW) {
            const int hh = lane >> 4, c8 = (lane & 15) * 8; const size_t o = (size_t)m * 512 + hh * 128 + c8;
            const f32x4 a0 = *(const f32x4*)(OFb + o), a1 = *(const f32x4*)(OFb + o + 4), b0 = *(const f32x4*)(OBb + o), b1 = *(const f32x4*)(OBb + o + 4);
            const f32x4 v0 = a0 + b0, v1 = a1 + b1;
            float ss = (v0.x * v0.x + v0.y * v0.y) + (v0.z * v0.z + v0.w * v0.w) + (v1.x * v1.x + v1.y * v1.y) + (v1.z * v1.z + v1.w * v1.w);
            ss += __shfl_xor(ss, 1); ss += __shfl_xor(ss, 2); ss += __shfl_xor(ss, 4); ss += __shfl_xor(ss, 8);
            const float rn = 1.0f / sqrtf(ss * (1.0f / 128.0f) + 1e-6f);
            const f32x4 g0 = *(const f32x4*)(ggain + c8), g1 = *(const f32x4*)(ggain + c8 + 4);
            const u32x4 gr = *(const u32x4*)(GG + o);
            float gt8[8];
#pragma unroll
            for (int e = 0; e < 4; ++e) { gt8[2 * e] = __builtin_bit_cast(float, gr[e] << 16); gt8[2 * e + 1] = __builtin_bit_cast(float, gr[e] & 0xffff0000u); }
            f32x4 r0, r1;
#pragma unroll
            for (int e = 0; e < 4; ++e) { r0[e] = v0[e] * rn * g0[e] * pg8::silu_f(gt8[e]); r1[e] = v1[e] * rn * g1[e] * pg8::silu_f(gt8[4 + e]); }
            u32x4 w; w.x = pk2(r0[0], r0[1]); w.y = pk2(r0[2], r0[3]); w.z = pk2(r1[0], r1[1]); w.w = pk2(r1[2], r1[3]);
            *(u32x4*)(AO + (size_t)m * DM + hh * 128 + c8) = w;
        }
    }
    SEAM(3);
    if (IN(4)) {
        pg8::Gemm g{AO, W_EOUT, MTOK, DM, DM}; pg8::StaticOrder S; S.init(MTOK, DM, G, bx);
        pg8::EpiResid E{x_in, XF, ALPHA};
        pg8::gemm_phase<pg8::EpiResid, pg8::StaticOrder, true, true>(lds, g, S, E);
    }
    SEAM(4);
    if (IN(5)) {
        for (int m = gw; m < MTOK; m += NGW) { f32x4 v[4];
#pragma unroll
            for (int j = 0; j < 4; ++j) v[j] = *((const f32x4*)(XF + (size_t)m * DM) + lane + 64 * j);
            ln_apply(v, ln_g + 0 * DM, ln_b + 0 * DM, lane); store_row_f32_bf16(v, XF + (size_t)m * DM, XB + (size_t)m * DM, lane); }
    }
    SEAM(5);
    if (IN(6)) {
        pg8::Gemm g{XB, W_FGU, MTOK, FGU_N, DM}; pg8::StaticOrder S; S.init(MTOK, FGU_N, G, bx);
        pg8::EpiSwiglu E{Hb, FGU_N / 256, 0};
        pg8::gemm_phase<pg8::EpiSwiglu, pg8::StaticOrder, true, true>(lds, g, S, E);
    }
    SEAM(6);
    if (IN(7)) {
        pg8::Gemm g{Hb, W_FDN, MTOK, DM, FF}; pg8::StaticOrder S; S.init(MTOK, DM, G, bx);
        pg8::EpiResid E{XF, XF, ALPHA};
        pg8::gemm_phase<pg8::EpiResid, pg8::StaticOrder, true, true>(lds, g, S, E);
    }
    SEAM(7);
    if (IN(8)) {
        for (int m = gw; m < MTOK; m += NGW) { f32x4 v[4];
#pragma unroll
            for (int j = 0; j < 4; ++j) v[j] = *((const f32x4*)(XF + (size_t)m * DM) + lane + 64 * j);
            ln_apply(v, ln_g + 1 * DM, ln_b + 1 * DM, lane); store_row_f32_bf16(v, XF + (size_t)m * DM, XB + (size_t)m * DM, lane); }
    }
    SEAM(8);
    if (IN(9)) {
        pg8::Gemm g{XB, W_OIN, MTOK, OIN_N, DM}; pg8::StaticOrder S; S.init(MTOK, OIN_N, G, bx);
        pg8::EpiOddIn E{CQ, CKV, KR};
        pg8::gemm_phase<pg8::EpiOddIn, pg8::StaticOrder, true, true>(lds, g, S, E);
    }
    SEAM(9);
    if (IN(10)) {
        const float* qg = args.in[I_QGAIN]; const float* kg = args.in[I_KVGAIN];
        for (int m = gw; m < MTOK; m += NGW) {
            const f32x4 cq = *((const f32x4*)(CQ + (size_t)m * 256) + lane);
            float ss = wave_sum((cq.x * cq.x + cq.y * cq.y) + (cq.z * cq.z + cq.w * cq.w));
            float rn = 1.0f / sqrtf(ss * (1.0f / 256.0f) + 1e-6f);
            const f32x4 g4 = *((const f32x4*)qg + lane);
            u32x2 w; w.x = pk2(cq.x * rn * g4.x, cq.y * rn * g4.y); w.y = pk2(cq.z * rn * g4.z, cq.w * rn * g4.w);
            *((u32x2*)(CQN + (size_t)m * 256) + lane) = w;
            const f32x2 ck = *((const f32x2*)(CKV + (size_t)m * 128) + lane);
            ss = wave_sum(ck.x * ck.x + ck.y * ck.y); rn = 1.0f / sqrtf(ss * (1.0f / 128.0f) + 1e-6f);
            const f32x2 g2 = *((const f32x2*)kg + lane);
            *((unsigned*)(CKVN + (size_t)m * 128) + lane) = pk2(ck.x * rn * g2.x, ck.y * rn * g2.y);
            const float val = KR[(size_t)m * 32 + (lane & 31)]; const float partner = __shfl_xor(val, 16);
            const int pos = m & (SEQ - 1), i = lane & 15; const float cs = ROPE[(pos * 16 + i) * 2], sn = ROPE[(pos * 16 + i) * 2 + 1];
            const float o = (lane & 16) ? (partner * sn + val * cs) : (val * cs - partner * sn);
            if (lane < 32) { const bf16 ob = (bf16)f2bf(o); bf16* kp = Kb + (size_t)m * 1536 + 64 + lane;
#pragma unroll
                for (int h = 0; h < 16; ++h) kp[h * 96] = ob; }
        }
    }
    SEAM(10);
    if (IN(11)) {
#ifndef SKIP_QUP
        { int kq = 256; asm volatile("" : "+s"(kq)); pg8::Gemm g{CQN, W_UQ, MTOK, UQ_N, kq}; pg8::StaticOrder S; S.init(MTOK, UQ_N, G, bx);
          pg8::EpiQUp E{Qb, ROPE, 0.10206207261596575f * LOG2E};
          pg8::gemm_phase<pg8::EpiQUp, pg8::StaticOrder, true, true>(lds, g, S, E); }
#endif
        __syncthreads();
#ifndef SKIP_KVUP
        { int kk = 128; asm volatile("" : "+s"(kk)); pg8::Gemm g{CKVN, W_UKV, MTOK, UKV_N, kk}; pg8::StaticOrder S; S.init(MTOK, UKV_N, G, bx);
          pg8::EpiKvUp E{Kb, VTb};
          pg8::gemm_phase<pg8::EpiKvUp, pg8::StaticOrder, true, true>(lds, g, S, E); }
#endif
    }
    SEAM(11);
    if (IN(12)) {
        const AttnP AP{Qb, Kb, VTb, AO2, nullptr, nullptr, nullptr};
        attn_phase<false>(lds, AP, G, bx);
    }
    SEAM(12);
    if (IN(13)) {
        pg8::Gemm g{AO2, W_OOUT, MTOK, DM, DM}; pg8::StaticOrder S; S.init(MTOK, DM, G, bx);
        pg8::EpiResid E{XF, XF, ALPHA};
        pg8::gemm_phase<pg8::EpiResid, pg8::StaticOrder, true, true>(lds, g, S, E);
    }
    SEAM(13);
    if (IN(14)) {
        LAS int* cntL = (LAS int*)lds; const float* rw = args.in[I_ROUTER];
        for (int ch = bx; ch < MTOK / 64; ch += G) {
            if (tid < 8) cntL[tid] = 0;
            __syncthreads();
            for (int i = 0; i < 8; ++i) { const int m = 64 * ch + 8 * wave + i; f32x4 v[4];
#pragma unroll
                for (int j = 0; j < 4; ++j) v[j] = *((const f32x4*)(XF + (size_t)m * DM) + lane + 64 * j);
                ln_apply(v, ln_g + 2 * DM, ln_b + 2 * DM, lane); store_row_f32_bf16(v, XF + (size_t)m * DM, XB + (size_t)m * DM, lane);
                float lg[8];
#pragma unroll
                for (int e = 0; e < 8; ++e) lg[e] = 0.f;
#pragma unroll
                for (int j = 0; j < 4; ++j)
#pragma unroll
                    for (int e4 = 0; e4 < 4; ++e4) { const int d = 256 * j + 4 * lane + e4; const f32x4 r0 = *(const f32x4*)(rw + (size_t)d * 8), r1 = *(const f32x4*)(rw + (size_t)d * 8 + 4); const float xv = v[j][e4];
#pragma unroll
                        for (int e = 0; e < 4; ++e) { lg[e] += xv * r0[e]; lg[4 + e] += xv * r1[e]; } }
#pragma unroll
                for (int e = 0; e < 8; ++e) lg[e] = wave_sum(lg[e]);
                int e0 = 0; float v0 = lg[0];
#pragma unroll
                for (int e = 1; e < 8; ++e) if (lg[e] > v0) { v0 = lg[e]; e0 = e; }
                int e1 = -1; float v1 = -3.0e38f;
#pragma unroll
                for (int e = 0; e < 8; ++e) if (e != e0 && lg[e] > v1) { v1 = lg[e]; e1 = e; }
                const float w0 = 1.0f / (1.0f + __expf(v1 - v0)), w1 = 1.0f - w0;
                if (lane == 0) { TOKE[2 * m] = e0; TOKE[2 * m + 1] = e1; TOKW[2 * m] = w0; TOKW[2 * m + 1] = w1; atomicAdd((int*)(cntL + e0), 1); atomicAdd((int*)(cntL + e1), 1); }
            }
            __syncthreads();
            if (tid < 8) BLKCNT[ch * 8 + tid] = cntL[tid];
            __syncthreads();
        }
    }
    SEAM(14);
    if (IN(15)) {
        LAS int* cnt_all = (LAS int*)lds; LAS int* pre = cnt_all + 2048; LAS int* segb = pre + 8; LAS int* w0cnt = segb + 8; LAS int* posL = w0cnt + 8; LAS int* tot = posL + 128;
        for (int i = tid; i < 2048; i += NTHR) cnt_all[i] = BLKCNT[i];
        __syncthreads();
        if (tid < 8) { int s = 0; for (int c2 = 0; c2 < 256; ++c2) s += cnt_all[c2 * 8 + tid]; tot[tid] = s; }
        __syncthreads();
        if (tid == 0) { int rowb = 0; for (int e = 0; e < 8; ++e) { segb[e] = rowb; rowb += ((tot[e] + 255) >> 8) << 8; }
            if (bx == 0) { int t = 0; for (int e = 0; e < 8; ++e) { const int nt = (tot[e] + 255) >> 8; for (int k = 0; k < nt; ++k) TILEE[t++] = e; } TILEE[MAXT] = t; } }
        __syncthreads();
        for (int ch = bx; ch < MTOK / 64; ch += G) {
            if (tid < 8) { int s = 0; for (int c2 = 0; c2 < ch; ++c2) s += cnt_all[c2 * 8 + tid]; pre[tid] = s; }
            int e_mine = -1, rank = 0, token = 0, kk = 0;
            if (tid < 128) { token = 64 * ch + (tid >> 1); kk = tid & 1; e_mine = TOKE[2 * token + kk]; }
            if (wave < 2) {
#pragma unroll
                for (int e = 0; e < 8; ++e) { const unsigned long long mask = __ballot(e_mine == e); if (e_mine == e) rank = __popcll(mask & ((1ull << lane) - 1ull)); if (wave == 0 && lane == 0) w0cnt[e] = __popcll(mask); }
            }
            __syncthreads();
            if (tid < 128) { if (wave == 1) rank += w0cnt[e_mine]; const int pos = segb[e_mine] + pre[e_mine] + rank; posL[tid] = pos; POS[2 * token + kk] = pos; }
            __syncthreads();
            for (int en = wave; en < 128; en += 8) { const int tk = 64 * ch + (en >> 1); const int pos = posL[en];
                const u32x4* src = (const u32x4*)(XB + (size_t)tk * DM); u32x4* dst = (u32x4*)(XP + (size_t)pos * DM);
                const u32x4 a = src[lane], b2 = src[lane + 64]; dst[lane] = a; dst[lane + 64] = b2; }
            __syncthreads();
        }
    }
    SEAM(15);
#define MOE_GU(ph, PASS) if (IN(ph)) { const int T = TILEE[MAXT], T1 = (T + 1) >> 1; const int t0 = (PASS) ? T1 : 0, t1 = (PASS) ? T : T1; \
        pg8::Gemm g{XP, W_MGU, 0, 0, DM}; pg8::MoeOrder S{t0, t1, FGU_N / 256, G, bx, FGU_N / 256, 0, TILEE}; pg8::EpiSwiglu E{HP, FGU_N / 256, t0}; \
        pg8::gemm_phase<pg8::EpiSwiglu, pg8::MoeOrder, true, true>(lds, g, S, E); }
#define MOE_DN(ph, PASS) if (IN(ph)) { const int T = TILEE[MAXT], T1 = (T + 1) >> 1; const int t0 = (PASS) ? T1 : 0, t1 = (PASS) ? T : T1; \
        pg8::Gemm g{HP, W_MDN, 0, 0, FF}; pg8::MoeOrder S{t0, t1, 4, G, bx, 4, t0, TILEE}; pg8::EpiBf16Out E{XP, t0}; \
        pg8::gemm_phase<pg8::EpiBf16Out, pg8::MoeOrder, true, true>(lds, g, S, E); }
    MOE_GU(16, 0) SEAM(16);
    MOE_DN(17, 0) SEAM(17);
    MOE_GU(18, 1) SEAM(18);
    MOE_DN(19, 1) SEAM(19);
    if (IN(20)) {
        for (int m = gw; m < MTOK; m += NGW) {
            const int p0 = POS[2 * m], p1 = POS[2 * m + 1]; const float w0 = TOKW[2 * m], w1 = TOKW[2 * m + 1];
            f32x4 v[4];
#pragma unroll
            for (int j = 0; j < 4; ++j) { const f32x4 xv = *((const f32x4*)(XF + (size_t)m * DM) + lane + 64 * j);
                const u32x2 y0 = *((const u32x2*)(XP + (size_t)p0 * DM) + lane + 64 * j), y1 = *((const u32x2*)(XP + (size_t)p1 * DM) + lane + 64 * j);
                f32x4 a, b2; a.x = __builtin_bit_cast(float, y0.x << 16); a.y = __builtin_bit_cast(float, y0.x & 0xffff0000u); a.z = __builtin_bit_cast(float, y0.y << 16); a.w = __builtin_bit_cast(float, y0.y & 0xffff0000u);
                b2.x = __builtin_bit_cast(float, y1.x << 16); b2.y = __builtin_bit_cast(float, y1.x & 0xffff0000u); b2.z = __builtin_bit_cast(float, y1.y << 16); b2.w = __builtin_bit_cast(float, y1.y & 0xffff0000u);
                v[j] = xv * ALPHA + a * w0 + b2 * w1; }
            ln_apply(v, ln_g + 3 * DM, ln_b + 3 * DM, lane);
            GAS f32x4* fr = (GAS f32x4*)(XF + (size_t)m * DM) + lane;
#pragma unroll
            for (int j = 0; j < 4; ++j) fr[64 * j] = v[j];
        }
    }
#undef IN
#undef SEAM
}

extern "C" void kernel_launch(void* const* d_in, const int* in_sizes, int n_in, void* d_out, int out_size, void* d_ws, size_t ws_size, hipStream_t stream) {
    static int grid = 0;
    if (grid == 0) {
        if (n_in != 24 || out_size != MTOK * DM || ws_size < WS_END) { fprintf(stderr, "kernel_launch: unexpected problem (n_in %d, out %d, ws %zu)\n", n_in, out_size, ws_size); grid = -1; return; }
        int dev = 0, cus = 0, per_cu = 0;
        if (hipGetDevice(&dev) != hipSuccess || hipDeviceGetAttribute(&cus, hipDeviceAttributeMultiprocessorCount, dev) != hipSuccess) { grid = -1; return; }
        if (hipFuncSetAttribute((const void*)mega_fwd, hipFuncAttributeMaxDynamicSharedMemorySize, LDS_BYTES) != hipSuccess) { fprintf(stderr, "kernel_launch: hipFuncSetAttribute failed\n"); grid = -1; return; }
        if (hipOccupancyMaxActiveBlocksPerMultiprocessor(&per_cu, (const void*)mega_fwd, NTHR, LDS_BYTES) != hipSuccess || per_cu < 1) { fprintf(stderr, "kernel_launch: occupancy query says %d\n", per_cu); }
        (void)hipGetLastError();
        grid = cus;
    }
    if (grid < 0) return;
    if (hipMemsetAsync((char*)d_ws + WS_CTL, 0, CTL_ZERO_BYTES, stream) != hipSuccess) return;
    Args a{};
    for (int i = 0; i < 24; ++i) a.in[i] = (const float*)d_in[i];
    a.out = (float*)d_out; a.ws = (unsigned char*)d_ws;
#if MK_PER_PHASE
    for (int p = 0; p < NPHASE; ++p) { a.ph_lo = p; a.ph_hi = p + 1; hipLaunchKernelGGL(mega_fwd, dim3(grid), dim3(NTHR), LDS_BYTES, stream, a); }
#else
    a.ph_lo = 0; a.ph_hi = NPHASE; hipLaunchKernelGGL(mega_fwd, dim3(grid), dim3(NTHR), LDS_BYTES, stream, a);
#endif
}
```

```cpp
#include <hip/hip_runtime.h>
#include <cstdio>
#include <cstdint>
namespace pg8 {
#define PG8_LAS __attribute__((address_space(3)))
typedef unsigned short bf16_t;
typedef short bf16x8 __attribute__((ext_vector_type(8)));
typedef float f32x4 __attribute__((ext_vector_type(4)));
typedef unsigned u32x4 __attribute__((ext_vector_type(4)));
constexpr int BM = 256, BK = 64, HALF = 128, HTB = HALF * BK * 2  , STAGE_BYTES = 8 * HTB, NXCD = 8, WGM = 8;

__host__ __device__ __forceinline__ int lds_byte(int r, int c) { const int st = (r >> 4) * 2 + (c >> 5), rr = r & 15, cc = c & 31, ob = rr * 64 + cc * 2; return st * 1024 + (ob ^ (((ob >> 9) & 1) << 5)); }
__host__ __device__ __forceinline__ void stage_rc(int b, int& R, int& C) { const int st = b / 1024, sb = b % 1024, swz = sb ^ (((sb >> 9) & 1) << 5); R = (st >> 1) * 16 + swz / 64; C = (st & 1) * 32 + (swz % 64) / 2; }
__host__ __device__ __forceinline__ int perm32(int rho) { const int n = rho >> 4, i = rho & 15; return 8 * (i >> 2) + 4 * n + (i & 3); }

struct Unit { int pm, pn; };
struct Gemm { const bf16_t* A; const bf16_t* Bt; int M, N, K; };

struct StaticOrder {
    int nM, nN, nwg, G, c;
    __host__ __device__ void init(int M, int N, int G_, int c_) { nM = M / BM; nN = N / BM; nwg = nM * nN; G = G_; c = c_; }
    __host__ __device__ bool next(int i, Unit& u) const {
        const long L = (long)i * G + c; if (L >= nwg) return false;
        int wgid = (int)L; { const int q = nwg / NXCD, r = nwg % NXCD, xcd = wgid % NXCD, off = wgid / NXCD; wgid = (xcd < r ? xcd * (q + 1) : r * (q + 1) + (xcd - r) * q) + off; }
        const int nig = WGM * nN, gid = wgid / nig, fm = gid * WGM, gsz = (nM - fm) < WGM ? (nM - fm) : WGM;
        u.pm = fm + ((wgid % nig) % gsz); u.pn = (wgid % nig) / gsz; return true;
    }
    __device__ __forceinline__ void a_ready(const Unit&) const {}
    __device__ __forceinline__ void done(const Unit&) const {}
};

__device__ __forceinline__ unsigned cvt_pk_bf16(float lo, float hi) { unsigned r; asm volatile("v_cvt_pk_bf16_f32 %0, %1, %2" : "=v"(r) : "v"(lo), "v"(hi)); return r; }
typedef float f32x2 __attribute__((ext_vector_type(2)));
typedef unsigned u32x2 __attribute__((ext_vector_type(2)));
__device__ __forceinline__ unsigned f2bf_rne(float f) { unsigned u = __builtin_bit_cast(unsigned, f); return (u + 0x7fffu + ((u >> 16) & 1u)) >> 16; }
__device__ __forceinline__ float silu_f(float g) { return g * __builtin_amdgcn_rcpf(1.0f + __expf(-g)); }
__device__ __forceinline__ u32x4 pack8(const f32x4 v0, const f32x4 v1) { u32x4 w; w.x = cvt_pk_bf16(v0[0], v0[1]); w.y = cvt_pk_bf16(v0[2], v0[3]); w.z = cvt_pk_bf16(v1[0], v1[1]); w.w = cvt_pk_bf16(v1[2], v1[3]); return w; }

struct EpiEvenIn {
    static constexpr bool PERM = true, AFTER_DRAIN = false;
    bf16_t *QG, *KG, *VG, *GG, *QD, *KD, *VDT; float* ALR;
    __device__ __forceinline__ void operator()(const f32x4 (&acc)[2][2][4][2], const Unit& u, int wr, int wc, int fr, int fq) const {
        const int pn = u.pn; const int row0 = u.pm * BM + wr * 64 + fr; const int cl = wc * 32 + 8 * fq;
        if (pn < 10) {
            bf16_t* base; int ld, c0; float sc = 1.f;
            if (pn == 0) { base = QG; ld = 256; c0 = 0; sc = 0.125f; }
            else if (pn == 1) { base = KG; ld = 256; c0 = 0; }
            else if (pn < 4) { base = VG; ld = 512; c0 = (pn - 2) * 256; }
            else if (pn < 6) { base = GG; ld = 512; c0 = (pn - 4) * 256; }
            else if (pn < 8) { base = QD; ld = 512; c0 = (pn - 6) * 256; sc = 0.125f * 1.4426950408889634f; }
            else { base = KD; ld = 512; c0 = (pn - 8) * 256; }
#pragma unroll
            for (int ai = 0; ai < 2; ++ai)
#pragma unroll
                for (int m = 0; m < 4; ++m) { bf16_t* rowp = base + (size_t)(row0 + ai * HALF + m * 16) * ld + c0 + cl;
#pragma unroll
                    for (int bj = 0; bj < 2; ++bj) *(u32x4*)(rowp + bj * HALF) = pack8(acc[ai][bj][m][0] * sc, acc[ai][bj][m][1] * sc); }
        } else if (pn < 12) {
            const int b = row0 >> 11, s0 = row0 & 2047;
#pragma unroll
            for (int bj = 0; bj < 2; ++bj) { bf16_t* vp0 = VDT + ((size_t)(b * 4 + 2 * (pn - 10) + bj) * 128 + cl) * 2048 + s0;
#pragma unroll
                for (int n = 0; n < 2; ++n)
#pragma unroll
                    for (int e = 0; e < 4; ++e) { bf16_t* vp = vp0 + (size_t)(4 * n + e) * 2048;
#pragma unroll
                        for (int ai = 0; ai < 2; ++ai)
#pragma unroll
                            for (int m = 0; m < 4; ++m) vp[ai * HALF + m * 16] = (bf16_t)f2bf_rne(acc[ai][bj][m][n][e]); } }
        } else {
            if (wc == 0) {
#pragma unroll
                for (int ai = 0; ai < 2; ++ai)
#pragma unroll
                    for (int m = 0; m < 4; ++m) { float* rowp = ALR + (size_t)(row0 + ai * HALF + m * 16) * 32 + 8 * fq; *(f32x4*)rowp = acc[ai][0][m][0]; *(f32x4*)(rowp + 4) = acc[ai][0][m][1]; }
            }
        }
    }
};
struct EpiResid {
    static constexpr bool PERM = false, AFTER_DRAIN = false;
    const float* base; float* out; float alpha;
    __device__ __forceinline__ void operator()(const f32x4 (&acc)[2][2][4][2], const Unit& u, int wr, int wc, int fr, int fq) const {
        const int col0 = u.pn * BM + wc * 32 + 4 * fq;
#pragma unroll
        for (int ai = 0; ai < 2; ++ai)
#pragma unroll
            for (int m = 0; m < 4; ++m) { const size_t off = (size_t)(u.pm * BM + ai * HALF + wr * 64 + m * 16 + fr) * 1024 + col0;
#pragma unroll
                for (int bj = 0; bj < 2; ++bj)
#pragma unroll
                    for (int n = 0; n < 2; ++n) { const size_t p = off + bj * HALF + n * 16; const f32x4 bs = *(const f32x4*)(base + p); *(f32x4*)(out + p) = bs * alpha + acc[ai][bj][m][n]; } }
    }
};
struct EpiSwiglu {
    static constexpr bool PERM = true, AFTER_DRAIN = false;
    bf16_t* H; int ncol, pm_off;
    __device__ __forceinline__ void operator()(const f32x4 (&acc)[2][2][4][2], const Unit& u, int wr, int wc, int fr, int fq) const {
        const int pnl = u.pn % ncol; const int rowb = (u.pm - pm_off) * BM + wr * 64 + fr; const int col = pnl * 128 + wc * 32 + 8 * fq;
#pragma unroll
        for (int ai = 0; ai < 2; ++ai)
#pragma unroll
            for (int m = 0; m < 4; ++m) { bf16_t* rowp = H + (size_t)(rowb + ai * HALF + m * 16) * 2816 + col;
                f32x4 h0, h1;
#pragma unroll
                for (int e = 0; e < 4; ++e) { h0[e] = silu_f(acc[ai][0][m][0][e]) * acc[ai][1][m][0][e]; h1[e] = silu_f(acc[ai][0][m][1][e]) * acc[ai][1][m][1][e]; }
                *(u32x4*)rowp = pack8(h0, h1); }
    }
};
struct EpiBf16Out {
    static constexpr bool PERM = true, AFTER_DRAIN = false;
    bf16_t* Y; int pm_add;
    __device__ __forceinline__ void operator()(const f32x4 (&acc)[2][2][4][2], const Unit& u, int wr, int wc, int fr, int fq) const {
        const int pnl = u.pn & 3; const int rowb = (u.pm + pm_add) * BM + wr * 64 + fr; const int col = pnl * BM + wc * 32 + 8 * fq;
#pragma unroll
        for (int ai = 0; ai < 2; ++ai)
#pragma unroll
            for (int m = 0; m < 4; ++m) { bf16_t* rowp = Y + (size_t)(rowb + ai * HALF + m * 16) * 1024 + col;
#pragma unroll
                for (int bj = 0; bj < 2; ++bj) *(u32x4*)(rowp + bj * HALF) = pack8(acc[ai][bj][m][0], acc[ai][bj][m][1]); }
    }
};
struct EpiOddIn {
    static constexpr bool PERM = false, AFTER_DRAIN = false;
    float *CQ, *CKV, *KR;
    __device__ __forceinline__ void operator()(const f32x4 (&acc)[2][2][4][2], const Unit& u, int wr, int wc, int fr, int fq) const {
        const size_t row0 = (size_t)(u.pm * BM + wr * 64 + fr);
        if (u.pn == 0) {
#pragma unroll
            for (int ai = 0; ai < 2; ++ai)
#pragma unroll
                for (int m = 0; m < 4; ++m)
#pragma unroll
                    for (int bj = 0; bj < 2; ++bj)
#pragma unroll
                        for (int n = 0; n < 2; ++n) *(f32x4*)(CQ + (row0 + ai * HALF + m * 16) * 256 + bj * HALF + wc * 32 + n * 16 + 4 * fq) = acc[ai][bj][m][n];
        } else {
#pragma unroll
            for (int ai = 0; ai < 2; ++ai)
#pragma unroll
                for (int m = 0; m < 4; ++m)
#pragma unroll
                    for (int n = 0; n < 2; ++n) *(f32x4*)(CKV + (row0 + ai * HALF + m * 16) * 128 + wc * 32 + n * 16 + 4 * fq) = acc[ai][0][m][n];
            if (wc == 0) {
#pragma unroll
                for (int ai = 0; ai < 2; ++ai)
#pragma unroll
                    for (int m = 0; m < 4; ++m)
#pragma unroll
                        for (int n = 0; n < 2; ++n) *(f32x4*)(KR + (row0 + ai * HALF + m * 16) * 32 + n * 16 + 4 * fq) = acc[ai][1][m][n];
            }
        }
    }
};
struct EpiQUp {
    static constexpr bool PERM = false, AFTER_DRAIN = false;
    bf16_t* Q; const float* rope; float qs;
    __device__ __forceinline__ void operator()(const f32x4 (&acc)[2][2][4][2], const Unit& u, int wr, int wc, int fr, int fq) const {
        const int row0 = u.pm * BM + wr * 64 + fr;
#pragma unroll
        for (int bj = 0; bj < 2; ++bj) { const int G = u.pn * 8 + bj * 4 + wc; bf16_t* colp = Q + G * 32 + 4 * fq;
            if ((G % 3) != 2) {
#pragma unroll
                for (int ai = 0; ai < 2; ++ai)
#pragma unroll
                    for (int m = 0; m < 4; ++m) { bf16_t* rowp = colp + (size_t)(row0 + ai * HALF + m * 16) * 1536;
                        const f32x4 a0 = acc[ai][bj][m][0] * qs, a1 = acc[ai][bj][m][1] * qs;
                        u32x2 w0, w1; w0.x = cvt_pk_bf16(a0[0], a0[1]); w0.y = cvt_pk_bf16(a0[2], a0[3]); w1.x = cvt_pk_bf16(a1[0], a1[1]); w1.y = cvt_pk_bf16(a1[2], a1[3]);
                        *(u32x2*)rowp = w0; *(u32x2*)(rowp + 16) = w1; }
            } else {
#pragma unroll
                for (int ai = 0; ai < 2; ++ai)
#pragma unroll
                    for (int m = 0; m < 4; ++m) { const int row = row0 + ai * HALF + m * 16; bf16_t* rowp = colp + (size_t)row * 1536;
                        const int pos = row & 2047; const f32x4* rp = (const f32x4*)(rope + (size_t)pos * 32 + 8 * fq); const f32x4 t0 = rp[0], t1 = rp[1];
                        const f32x4 cs = (f32x4){t0[0], t0[2], t1[0], t1[2]} * qs, sn = (f32x4){t0[1], t0[3], t1[1], t1[3]} * qs;
                        const f32x4 a0 = acc[ai][bj][m][0] * cs - acc[ai][bj][m][1] * sn, a1 = acc[ai][bj][m][0] * sn + acc[ai][bj][m][1] * cs;
                        u32x2 w0, w1; w0.x = cvt_pk_bf16(a0[0], a0[1]); w0.y = cvt_pk_bf16(a0[2], a0[3]); w1.x = cvt_pk_bf16(a1[0], a1[1]); w1.y = cvt_pk_bf16(a1[2], a1[3]);
                        *(u32x2*)rowp = w0; *(u32x2*)(rowp + 16) = w1;
                        asm volatile("" ::: "memory"); }
            } }
    }
};
struct EpiKvUp {
    static constexpr bool PERM = true, AFTER_DRAIN = false;
    bf16_t *K, *VT;
    __device__ __forceinline__ void operator()(const f32x4 (&acc)[2][2][4][2], const Unit& u, int wr, int wc, int fr, int fq) const {
        const int row0 = u.pm * BM + wr * 64 + fr;
        if (wc < 2) {
#pragma unroll
            for (int bj = 0; bj < 2; ++bj) { bf16_t* colp = K + (2 * u.pn + bj) * 96 + wc * 32 + 8 * fq;
#pragma unroll
                for (int ai = 0; ai < 2; ++ai)
#pragma unroll
                    for (int m = 0; m < 4; ++m) *(u32x4*)(colp + (size_t)(row0 + ai * HALF + m * 16) * 1536) = pack8(acc[ai][bj][m][0], acc[ai][bj][m][1]); }
        } else {
            const int b = row0 >> 11, s0 = row0 & 2047;
#pragma unroll
            for (int bj = 0; bj < 2; ++bj) { bf16_t* vp0 = VT + ((size_t)(b * 16 + 2 * u.pn + bj) * 64 + (wc - 2) * 32 + 8 * fq) * 2048 + s0;
#pragma unroll
                for (int n = 0; n < 2; ++n)
#pragma unroll
                    for (int e = 0; e < 4; ++e) { bf16_t* vp = vp0 + (size_t)(4 * n + e) * 2048;
#pragma unroll
                        for (int ai = 0; ai < 2; ++ai)
#pragma unroll
                            for (int m = 0; m < 4; ++m) vp[ai * HALF + m * 16] = (bf16_t)f2bf_rne(acc[ai][bj][m][n][e]); } }
        }
    }
};
struct MoeOrder {
    int t0, t1, ncol, G, c, bstride, pm_sub; const int* tile_e;
    __device__ __forceinline__ bool next(int i, Unit& u) const {
        const int L = i * G + c; if (L >= (t1 - t0) * ncol) return false;
        const int tile = t0 + L / ncol, pn = L % ncol;
        u.pm = tile - pm_sub; u.pn = tile_e[tile] * bstride + pn; return true;
    }
    __device__ __forceinline__ void a_ready(const Unit&) const {}
    __device__ __forceinline__ void done(const Unit&) const {}
};

template <class Epi, class Sched, bool ALIGN_EPI = false, bool SP2 = false>
__device__ __forceinline__ void gemm_phase(PG8_LAS unsigned char* lds, const Gemm g, const Sched& S, const Epi& E) {
    const int tid = threadIdx.x, wid = __builtin_amdgcn_readfirstlane(tid >> 6), lane = tid & 63, wr = wid >> 2, wc = wid & 3, fr = lane & 15, fq = lane >> 4;
    const int K = g.K, nt = K / BK;
    unsigned voffA[2], voffB[2];
#pragma unroll
    for (int i = 0; i < 2; ++i) { int R, C; stage_rc(tid * 16 + i * 8192, R, C); const int Rb = Epi::PERM ? ((R & ~31) + perm32(R & 31)) : R;
        voffA[i] = (unsigned)(R * K + C) * 2u; voffB[i] = (unsigned)(Rb * K + C) * 2u; }
    const size_t kstep = (size_t)(BK * 2);
    const size_t hstep = (size_t)HALF * K * 2;
    const size_t tstep = 2 * hstep;
    const unsigned ldsw = (unsigned)wid * 1024u;
    const int aoff = lds_byte(wr * 64 + fr, fq * 8), boff = lds_byte(wc * 32 + fr, fq * 8);
#define PG8_SA(b, h) (((b) * 2 + (h)) * HTB)
#define PG8_SB(b, h) ((4 + (b) * 2 + (h)) * HTB)
#define PG8_STAGE(bufoff, gbase, voff) do { _Pragma("unroll") for (int _i = 0; _i < 2; ++_i) \
        __builtin_amdgcn_global_load_lds((const unsigned*)((const char*)(gbase) + (voff)[_i]), (PG8_LAS unsigned*)(lds + (bufoff) + ldsw + _i * 8192), 16, 0, 0); } while (0)
#define PG8_LDA(dst, b, h) do { _Pragma("unroll") for (int m = 0; m < 4; ++m) _Pragma("unroll") for (int k = 0; k < 2; ++k) dst[m][k] = *(const PG8_LAS bf16x8*)(lds + PG8_SA(b, h) + aoff + m * 2048 + k * 1024); } while (0)
#define PG8_LDB(dst, b, h) do { _Pragma("unroll") for (int n = 0; n < 2; ++n) _Pragma("unroll") for (int k = 0; k < 2; ++k) dst[n][k] = *(const PG8_LAS bf16x8*)(lds + PG8_SB(b, h) + boff + n * 2048 + k * 1024); } while (0)
#define PG8_MMA(ai, bj, At, Bt) do { __builtin_amdgcn_s_setprio(1); _Pragma("unroll") for (int m = 0; m < 4; ++m) _Pragma("unroll") for (int n = 0; n < 2; ++n) _Pragma("unroll") for (int k = 0; k < 2; ++k) \
        acc[ai][bj][m][n] = __builtin_amdgcn_mfma_f32_16x16x32_bf16(Bt[n][k], At[m][k], acc[ai][bj][m][n], 0, 0, 0); __builtin_amdgcn_s_setprio(0); } while (0)
#define PG8_WAIT_V(n) asm volatile("s_waitcnt vmcnt(" #n ")" ::: "memory")
#define PG8_WAIT_L(n) asm volatile("s_waitcnt lgkmcnt(" #n ")" ::: "memory")
#define PG8_BAR __builtin_amdgcn_s_barrier()
#define PG8_SCHED __builtin_amdgcn_sched_barrier(0)
    Unit cur, nxt; int ui = 0;
    if (!S.next(0, cur)) return;
    f32x4 acc[2][2][4][2];
#pragma unroll
    for (int a = 0; a < 2; ++a)
#pragma unroll
        for (int b = 0; b < 2; ++b)
#pragma unroll
            for (int m = 0; m < 4; ++m)
#pragma unroll
                for (int n = 0; n < 2; ++n) acc[a][b][m][n] = (f32x4){0.f, 0.f, 0.f, 0.f};
    bf16x8 At[4][2], B0[2][2], B1[2][2];
    const char* cA = (const char*)g.A + (size_t)cur.pm * tstep; const char* cB = (const char*)g.Bt + (size_t)cur.pn * tstep;
    S.a_ready(cur);
    if constexpr (SP2) {
        PG8_STAGE(PG8_SB(0, 0), cB, voffB); PG8_STAGE(PG8_SB(0, 1), cB + hstep, voffB); PG8_STAGE(PG8_SA(0, 0), cA, voffA); PG8_STAGE(PG8_SA(0, 1), cA + hstep, voffA);
        if (wr == 1) PG8_BAR;
        PG8_WAIT_V(2); PG8_BAR;
        PG8_STAGE(PG8_SB(1, 0), cB + kstep, voffB); PG8_STAGE(PG8_SA(1, 0), cA + kstep, voffA); PG8_STAGE(PG8_SB(1, 1), cB + hstep + kstep, voffB);
        PG8_WAIT_V(6); PG8_BAR;
    } else {
        PG8_STAGE(PG8_SB(0, 0), cB, voffB); PG8_STAGE(PG8_SA(0, 0), cA, voffA); PG8_STAGE(PG8_SB(0, 1), cB + hstep, voffB); PG8_STAGE(PG8_SA(0, 1), cA + hstep, voffA);
        if (wr == 1) PG8_BAR;
        PG8_WAIT_V(4); PG8_BAR;
        PG8_STAGE(PG8_SB(1, 0), cB + kstep, voffB); PG8_STAGE(PG8_SA(1, 0), cA + kstep, voffA); PG8_STAGE(PG8_SB(1, 1), cB + hstep + kstep, voffB);
        PG8_WAIT_V(6); PG8_BAR;
    }
    for (;;) {
        const bool has_next = S.next(ui + 1, nxt);
        const char* nA = has_next ? (const char*)g.A + (size_t)nxt.pm * tstep : cA; const char* nB = has_next ? (const char*)g.Bt + (size_t)nxt.pn * tstep : cB;
        for (int t = 0; t < nt; t += 2) {
            const bool last = (t == nt - 2);
            const char* a1 = cA + (size_t)(t + 1) * kstep;
            const char* a2 = last ? nA : cA + (size_t)(t + 2) * kstep; const char* b2 = last ? nB : cB + (size_t)(t + 2) * kstep;
            const char* a3 = a2 + kstep; const char* b3 = b2 + kstep;
            if (last && has_next) S.a_ready(nxt);
            if constexpr (SP2) {
            PG8_LDB(B0, 0, 0); PG8_LDB(B1, 0, 1); PG8_SCHED; PG8_LDA(At, 0, 0); PG8_STAGE(PG8_SA(1, 1), a1 + hstep, voffA);
            PG8_WAIT_V(8); PG8_WAIT_L(0); PG8_BAR; PG8_MMA(0, 0, At, B0); PG8_MMA(0, 1, At, B1); PG8_BAR; PG8_SCHED;
            PG8_LDA(At, 0, 1); PG8_STAGE(PG8_SB(0, 0), b2, voffB); PG8_STAGE(PG8_SB(0, 1), b2 + hstep, voffB); PG8_STAGE(PG8_SA(0, 0), a2, voffA);
            PG8_WAIT_V(8); PG8_WAIT_L(0); PG8_BAR; PG8_MMA(1, 0, At, B0); PG8_MMA(1, 1, At, B1); PG8_BAR; PG8_SCHED;
            PG8_LDB(B0, 1, 0); PG8_LDB(B1, 1, 1); PG8_SCHED; PG8_LDA(At, 1, 0); PG8_STAGE(PG8_SA(0, 1), a2 + hstep, voffA);
            PG8_WAIT_V(8); PG8_WAIT_L(0); PG8_BAR; PG8_MMA(0, 0, At, B0); PG8_MMA(0, 1, At, B1); PG8_BAR; PG8_SCHED;
            PG8_LDA(At, 1, 1); PG8_STAGE(PG8_SB(1, 0), b3, voffB); PG8_STAGE(PG8_SB(1, 1), b3 + hstep, voffB); PG8_STAGE(PG8_SA(1, 0), a3, voffA);
            PG8_WAIT_V(8); PG8_WAIT_L(0); PG8_BAR; PG8_MMA(1, 0, At, B0); PG8_MMA(1, 1, At, B1); PG8_BAR; PG8_SCHED;
            } else {
            PG8_LDB(B0, 0, 0); PG8_SCHED; PG8_LDA(At, 0, 0); PG8_STAGE(PG8_SA(1, 1), a1 + hstep, voffA);
            PG8_WAIT_L(8); PG8_BAR; PG8_WAIT_L(0); PG8_MMA(0, 0, At, B0); PG8_BAR; PG8_SCHED;
            PG8_LDB(B1, 0, 1); PG8_STAGE(PG8_SB(0, 0), b2, voffB);
            PG8_BAR; PG8_WAIT_L(0); PG8_MMA(0, 1, At, B1); PG8_BAR;
            PG8_LDA(At, 0, 1); PG8_STAGE(PG8_SA(0, 0), a2, voffA);
            PG8_BAR; PG8_WAIT_L(0); PG8_MMA(1, 0, At, B0); PG8_BAR; PG8_SCHED;
            PG8_STAGE(PG8_SB(0, 1), b2 + hstep, voffB);
            PG8_WAIT_V(6); PG8_BAR; PG8_MMA(1, 1, At, B1); PG8_BAR;
            PG8_LDB(B0, 1, 0); PG8_SCHED; PG8_LDA(At, 1, 0); PG8_STAGE(PG8_SA(0, 1), a2 + hstep, voffA);
            PG8_WAIT_L(8); PG8_BAR; PG8_WAIT_L(0); PG8_MMA(0, 0, At, B0); PG8_BAR; PG8_SCHED;
            PG8_LDB(B1, 1, 1); PG8_STAGE(PG8_SB(1, 0), b3, voffB);
            PG8_BAR; PG8_WAIT_L(0); PG8_MMA(0, 1, At, B1); PG8_BAR;
            PG8_LDA(At, 1, 1); PG8_STAGE(PG8_SA(1, 0), a3, voffA);
            PG8_BAR; PG8_WAIT_L(0); PG8_MMA(1, 0, At, B0); PG8_BAR; PG8_SCHED;
            PG8_STAGE(PG8_SB(1, 1), b3 + hstep, voffB);
            PG8_WAIT_V(6); PG8_BAR; PG8_MMA(1, 1, At, B1); PG8_BAR;
            }
        }
        if constexpr (ALIGN_EPI) { if (wr == 0) PG8_BAR; }
        if constexpr (!Epi::AFTER_DRAIN) { E(acc, cur, wr, wc, fr, fq); S.done(cur); }
        if (!has_next) break;
#pragma unroll
        for (int a = 0; a < 2; ++a)
#pragma unroll
            for (int b = 0; b < 2; ++b)
#pragma unroll
                for (int m = 0; m < 4; ++m)
#pragma unroll
                    for (int n = 0; n < 2; ++n) acc[a][b][m][n] = (f32x4){0.f, 0.f, 0.f, 0.f};
        cur = nxt; cA = nA; cB = nB; ++ui;
        if constexpr (ALIGN_EPI) { if (wr == 1) PG8_BAR; }
    }
    PG8_WAIT_V(0);
    if constexpr (!ALIGN_EPI) { if (wr == 0) PG8_BAR; }
    PG8_BAR;
    if constexpr (Epi::AFTER_DRAIN) { E.fused(acc, cur, wr, wc, fr, fq, lds, wid, lane); S.done(cur); }
#undef PG8_SA
#undef PG8_SB
#undef PG8_STAGE
#undef PG8_LDA
#undef PG8_LDB
#undef PG8_MMA
#undef PG8_WAIT_V
#undef PG8_WAIT_L
#undef PG8_BAR
#undef PG8_SCHED
}
}

#define GAS __attribute__((address_space(1)))
#define LAS __attribute__((address_space(3)))
typedef unsigned short bf16;
typedef float f32x4 __attribute__((ext_vector_type(4)));
typedef float f32x2 __attribute__((ext_vector_type(2)));
typedef float f32x16 __attribute__((ext_vector_type(16)));
typedef short bf16x8 __attribute__((ext_vector_type(8)));
typedef unsigned u32x4 __attribute__((ext_vector_type(4)));
typedef unsigned u32x2 __attribute__((ext_vector_type(2)));
typedef __bf16 bf16x2_t __attribute__((ext_vector_type(2)));

constexpr int NWAVES = 8, NTHR = 512;
constexpr int NB = 8, SEQ = 2048, DM = 1024, MTOK = NB * SEQ;
constexpr int EIN_SRC = 3104, EIN_N = 3328, FF = 2816, FGU_N = 2 * FF, OIN_SRC = 416, OIN_N = 512, UQ_N = 1536, UKV_N = 2048, NEXP = 8;
constexpr int MAXT = 136, HALFT = 68;
constexpr float ALPHA = 1.4142135623730951f;
constexpr float LOG2E = 1.4426950408889634f;
constexpr float LAM_INIT = 0.2f;

constexpr size_t MiB = 1u << 20;
constexpr size_t WS_CTL = 0, CTL_ZERO_BYTES = 1 * MiB;
constexpr size_t WS_W_EIN = 1 * MiB, WS_W_EOUT = 8 * MiB, WS_W_FGU = 10 * MiB, WS_W_FDN = 21 * MiB, WS_W_OIN = 27 * MiB, WS_W_UQ = 28 * MiB, WS_W_UKV = 29 * MiB,
                 WS_W_OOUT = 30 * MiB, WS_W_MGU = 32 * MiB, WS_W_MDN = 120 * MiB;
constexpr size_t WS_TAB = 164 * MiB;
constexpr size_t WS_ROPE = WS_TAB, WS_LUT = WS_TAB + 256 * 1024, WS_TOKE = WS_TAB + 512 * 1024, WS_TOKW = WS_TAB + 640 * 1024, WS_POS = WS_TAB + 768 * 1024,
                 WS_BLKCNT = WS_TAB + 896 * 1024, WS_TILEE = WS_TAB + 960 * 1024;
constexpr size_t WS_XB = 166 * MiB;
constexpr size_t WS_QG = 198 * MiB, WS_KG = 206 * MiB, WS_VG = 214 * MiB, WS_GG = 230 * MiB, WS_QD = 246 * MiB, WS_KD = 262 * MiB, WS_VDT = 278 * MiB, WS_ALR = 294 * MiB,
                 WS_OB = 296 * MiB, WS_AO = 328 * MiB, WS_OF = WS_XB;
constexpr size_t WS_H = 198 * MiB;
constexpr size_t WS_CQ = 198 * MiB, WS_CKV = 214 * MiB, WS_KR = 222 * MiB, WS_CQN = 224 * MiB, WS_CKVN = 232 * MiB, WS_Q = 236 * MiB, WS_K = 284 * MiB, WS_VT = 332 * MiB, WS_AO2 = 198 * MiB;
constexpr size_t WS_XP = 198 * MiB, WS_HP = 266 * MiB;
constexpr size_t WS_END = 364 * MiB;
static_assert(WS_HP + (size_t)HALFT * 256 * FF * 2 <= WS_END && WS_XP + (size_t)MAXT * 256 * DM * 2 <= WS_HP, "moe map");
constexpr int CW_BAR = 4096;
constexpr int RING_BYTES = 131072, LDSCTL_OFF = RING_BYTES, MISC_OFF = LDSCTL_OFF + 320, LDS_BYTES = 147456;

#define RLX_AGENT __ATOMIC_RELAXED, __HIP_MEMORY_SCOPE_AGENT
#define LDS_WAIT() asm volatile("s_waitcnt lgkmcnt(0)" ::: "memory")
__device__ __forceinline__ unsigned f2bf(float f) { unsigned u = __builtin_bit_cast(unsigned, f); return (u + 0x7fffu + ((u >> 16) & 1u)) >> 16; }
__device__ __forceinline__ unsigned pk2(float lo, float hi) { return f2bf(lo) | (f2bf(hi) << 16); }
__device__ __forceinline__ float bf2f(unsigned short b) { return __builtin_bit_cast(float, (unsigned)b << 16); }
__device__ __forceinline__ unsigned cvtpk(float lo, float hi) { f32x2 v = {lo, hi}; bf16x2_t b = __builtin_convertvector(v, bf16x2_t); return __builtin_bit_cast(unsigned, b); }
__device__ __forceinline__ float wave_sum(float v) {
#pragma unroll
    for (int o = 1; o < 64; o <<= 1) v += __shfl_xor(v, o);
    return v;
}

#define XB_TMO      128
#define XB_XCNT(j)  (256  + 64 * (j))
#define XB_XSUB(j)  (1280 + 64 * (j))
#define XB_XGEN(j)  (2304 + 64 * (j))
#define XB_TOP      3328
#define XB_TOPGEN   3392
#define XCD_BAR_WORDS 3456
#define XB_SPIN_CAP (1u << 18)
__device__ __forceinline__ unsigned xb_ld(unsigned* p)              { return __hip_atomic_load(p, __ATOMIC_RELAXED, __HIP_MEMORY_SCOPE_AGENT); }
__device__ __forceinline__ unsigned xb_add(unsigned* p, unsigned v) { return __hip_atomic_fetch_add(p, v, __ATOMIC_RELAXED, __HIP_MEMORY_SCOPE_AGENT); }
__device__ __forceinline__ unsigned xb_xcc_id() { return (unsigned)__builtin_amdgcn_s_getreg((3 << 11) | 20) & 0xFu; }
#define XB_SPIN(cond, bar) do { unsigned _sp = 0; while (cond) { __builtin_amdgcn_s_sleep(1); \
    if ((++_sp & 255u) == 0u) { if (xb_ld(&(bar)[XB_TMO])) break; if (_sp > XB_SPIN_CAP) { atomicAdd(&(bar)[XB_TMO], 1u); break; } } } } while (0)
struct XcdBarrier { unsigned* bar; unsigned x; volatile LAS unsigned* st; };
__device__ __forceinline__ XcdBarrier xcd_barrier_post(unsigned* bar, volatile LAS unsigned* st) {
    XcdBarrier b; b.bar = bar; b.x = xb_xcc_id(); b.st = st;
    if (threadIdx.x == 0) (void)xb_add(&bar[XB_XCNT(b.x)], 1u);
    return b;
}
__device__ __forceinline__ void xcd_barrier_complete(unsigned* bar, unsigned x, unsigned& nloc, unsigned& nx) {
    const unsigned G = gridDim.x * gridDim.y * gridDim.z;
    unsigned sum, cnt, mine, sp = 0u;
    for (;;) {
        sum = 0u; cnt = 0u; mine = 0u;
#pragma unroll
        for (unsigned j = 0; j < 16; ++j) { const unsigned c = xb_ld(&bar[XB_XCNT(j)]); sum += c; cnt += (c > 0u) ? 1u : 0u; mine = (j == x) ? c : mine; }
        if (sum == G) break;
        __builtin_amdgcn_s_sleep(1);
        if ((++sp & 255u) == 0u) { if (xb_ld(&bar[XB_TMO])) break; if (sp > XB_SPIN_CAP) { atomicAdd(&bar[XB_TMO], 1u); break; } }
    }
    nloc = mine > 0u ? mine : 1u; nx = cnt > 0u ? cnt : 1u;
}
__device__ __forceinline__ void xcd_barrier(const XcdBarrier& b) {
    asm volatile("s_waitcnt vmcnt(0)" ::: "memory");
    __syncthreads();
    if (threadIdx.x == 0) {
        unsigned* bar = b.bar;
        __builtin_amdgcn_s_waitcnt(0);
        unsigned nloc = b.st[0], nx = b.st[1];
        if (nloc == 0u) { xcd_barrier_complete(bar, b.x, nloc, nx); b.st[0] = nloc; b.st[1] = nx; }
        const unsigned old = xb_add(&bar[XB_XSUB(b.x)], 1u);
        const unsigned gen = old / nloc;
        if (old + 1u == (gen + 1u) * nloc) {
            __builtin_amdgcn_fence(__ATOMIC_RELEASE, "agent");
            asm volatile("s_waitcnt vmcnt(0)" ::: "memory");
            const unsigned og = xb_add(&bar[XB_TOP], 1u);
            const unsigned tg = og / nx;
            if (og + 1u == (tg + 1u) * nx) xb_add(&bar[XB_TOPGEN], 1u);
            else XB_SPIN(xb_ld(&bar[XB_TOPGEN]) == tg, bar);
            __builtin_amdgcn_fence(__ATOMIC_ACQUIRE, "agent");
            xb_add(&bar[XB_XGEN(b.x)], 1u);
            asm volatile("s_waitcnt vmcnt(0)" ::: "memory");
        } else {
            XB_SPIN(xb_ld(&bar[XB_XGEN(b.x)]) == gen, bar);
            __builtin_amdgcn_fence(__ATOMIC_ACQUIRE, "agent");
            asm volatile("s_waitcnt vmcnt(0)" ::: "memory");
        }
    }
    __syncthreads();
}

__device__ __forceinline__ void tr_item(const float* W, int K, int N, bf16* WT, int dstrow0, LAS float* scr, int kb, int n0, int lane) {
    const int k0 = 64 * kb;
#pragma unroll 8
    for (int i = 0; i < 32; ++i) { const int kk = 2 * i + (lane >> 5); scr[kk * 33 + (lane & 31)] = W[(size_t)(k0 + kk) * N + n0 + (lane & 31)]; }
    LDS_WAIT(); asm volatile("" ::: "memory");
    const int c = lane & 7;
#pragma unroll
    for (int j = 0; j < 4; ++j) { const int n = (lane >> 3) + 8 * j; const LAS float* s = scr + (8 * c) * 33 + n;
        u32x4 o; o.x = pk2(s[0 * 33], s[1 * 33]); o.y = pk2(s[2 * 33], s[3 * 33]); o.z = pk2(s[4 * 33], s[5 * 33]); o.w = pk2(s[6 * 33], s[7 * 33]);
        *(GAS u32x4*)(WT + (size_t)(dstrow0 + n) * K + k0 + 8 * c) = o; }
    LDS_WAIT(); asm volatile("" ::: "memory");
}
template <int MODE>
__device__ __forceinline__ void tr_matrix(const float* W, int K, int N, bf16* WT, int row_off, LAS float* scr, int gw, int NGW, int lane) {
    const int nblk = N / 32, nitems = (K / 64) * nblk;
    for (int it = gw; it < nitems; it += NGW) { const int kb = it / nblk, n0 = 32 * (it % nblk); int d;
        if (MODE == 0) d = n0;
        else if (MODE == 1) d = (n0 < 1536) ? n0 : (n0 == 1536 ? 3072 : n0 - 32);
        else d = 256 * (n0 >> 7) + (n0 & 127) + (MODE == 3 ? 128 : 0);
        tr_item(W, K, N, WT, row_off + d, scr, kb, n0, lane); }
}
__device__ __forceinline__ void row_to_bf16(const float* xrow, bf16* orow, int lane) {
    const GAS f32x4* xr = (const GAS f32x4*)xrow + lane; GAS unsigned long long* o8 = (GAS unsigned long long*)orow + lane;
#pragma unroll
    for (int j = 0; j < 4; ++j) { const f32x4 v = xr[64 * j]; o8[64 * j] = (unsigned long long)pk2(v.x, v.y) | ((unsigned long long)pk2(v.z, v.w) << 32); }
}
__device__ __forceinline__ void ln_apply(f32x4 (&v)[4], const float* g, const float* b, int lane) {
    float s = 0.f;
#pragma unroll
    for (int j = 0; j < 4; ++j) s += (v[j].x + v[j].y) + (v[j].z + v[j].w);
    const float mean = wave_sum(s) * (1.f / DM); float s2 = 0.f;
#pragma unroll
    for (int j = 0; j < 4; ++j) { v[j] = v[j] - mean; s2 += (v[j].x * v[j].x + v[j].y * v[j].y) + (v[j].z * v[j].z + v[j].w * v[j].w); }
    const float rstd = 1.f / sqrtf(wave_sum(s2) * (1.f / DM) + 1e-5f);
#pragma unroll
    for (int j = 0; j < 4; ++j) { const f32x4 gg = *((const f32x4*)g + lane + 64 * j), bb = *((const f32x4*)b + lane + 64 * j); v[j] = v[j] * rstd * gg + bb; }
}
__device__ __forceinline__ void store_row_f32_bf16(const f32x4 (&v)[4], float* frow, bf16* brow, int lane) {
    GAS f32x4* fr = (GAS f32x4*)frow + lane; GAS unsigned long long* o8 = (GAS unsigned long long*)brow + lane;
#pragma unroll
    for (int j = 0; j < 4; ++j) { fr[64 * j] = v[j]; o8[64 * j] = (unsigned long long)pk2(v[j].x, v[j].y) | ((unsigned long long)pk2(v[j].z, v[j].w) << 32); }
}

struct AttnP {
    const bf16* Q; const bf16* K; const bf16* VT; bf16* O;
    const float* lut;
    const float* dlam;
    const float* dgain;
};
template <bool DIFF>
__device__ __forceinline__ void attn_phase(LAS unsigned char* lds, const AttnP& P, int G, int c) {
    constexpr int KW = DIFF ? 128 : 96, DQ = DIFF ? 64 : 96, DV = DIFF ? 128 : 64, NH = DIFF ? 4 : 16;
    constexpr int LDQ = DIFF ? 512 : 1536, LDK = DIFF ? 512 : 1536, HQ = DIFF ? 128 : 96;
    constexpr int KPITCH = KW * 2 + 16, VPITCH = 144, KBYTES = 64 * KPITCH, VBYTES = DV * VPITCH, STAGE = KBYTES + VBYTES;
    constexpr int NDS = DQ / 16, NRB = DV / 32, KPR = KW / 8, NKPIECE = 64 * KPR, NVPIECE = DV * 8;
    constexpr int NKI = (NKPIECE + NTHR - 1) / NTHR, NVI = (NVPIECE + NTHR - 1) / NTHR;
    constexpr int QROWS = DIFF ? 128 : 256, NQB = SEQ / QROWS, NUNITS = NB * NH * NQB;
    constexpr int LUT_OFF = 2 * STAGE;
    static_assert(LUT_OFF + (DIFF ? 8192 : 0) <= RING_BYTES && 2 * STAGE >= (DIFF ? 65536 : 0), "attn lds");
    const int tid = threadIdx.x, lane = tid & 63, wid = __builtin_amdgcn_readfirstlane(tid >> 6), r = lane & 31, h2 = lane >> 5;
    const int pir = (r & ~12) | ((r & 4) << 1) | ((r & 8) >> 1);
    float lam = 0.f;
    if (DIFF) {
        LAS float* L = (LAS float*)(lds + LUT_OFF);
        for (int i = tid; i < 4 * 512; i += NTHR) L[i] = P.lut[i];
        const float a = P.dlam[lane] * P.dlam[64 + lane], b2 = P.dlam[128 + lane] * P.dlam[192 + lane];
        lam = __expf(wave_sum(a)) - __expf(wave_sum(b2)) + LAM_INIT;
        __syncthreads();
    }
    for (int unit = c; unit < NUNITS; unit += G) {
        int b, h, q0, map;
        if (DIFF) { const int qb = unit & 15; h = (unit >> 4) & 3; b = unit >> 6; map = wid >> 2; q0 = qb * 128 + 32 * (wid & 3); }
        else { const int qb = unit & 7; h = (unit >> 3) & 15; b = unit >> 7; map = 0; q0 = qb * 256 + 32 * wid; }
        const size_t tok0 = (size_t)b * SEQ;
        bf16x8 qf[NDS];
        { const bf16* qp = P.Q + (tok0 + q0 + r) * LDQ + h * HQ + map * 64 + 8 * h2;
#pragma unroll
          for (int ds = 0; ds < NDS; ++ds) qf[ds] = *(const bf16x8*)(qp + 16 * ds); }
        const bf16* Kb = P.K + tok0 * LDK + h * HQ;
        const bf16* Vb = P.VT + (size_t)(b * NH + h) * DV * SEQ;
        u32x4 kst[NKI], vst[NVI];
#define ATT_LOAD(t) do { \
        _Pragma("unroll") for (int i = 0; i < NKI; ++i) { const int p = tid + i * NTHR; if (NKPIECE % NTHR == 0 || p < NKPIECE) { const int row = p / KPR, cp = p % KPR; kst[i] = *(const u32x4*)(Kb + (size_t)(64 * (t) + row) * LDK + 8 * cp); } } \
        _Pragma("unroll") for (int i = 0; i < NVI; ++i) { const int p = tid + i * NTHR; const int row = p >> 3, cp = p & 7; vst[i] = *(const u32x4*)(Vb + (size_t)row * SEQ + 64 * (t) + 8 * cp); } } while (0)
#define ATT_STORE(buf) do { \
        _Pragma("unroll") for (int i = 0; i < NKI; ++i) { const int p = tid + i * NTHR; if (NKPIECE % NTHR == 0 || p < NKPIECE) { const int row = p / KPR, cp = p % KPR; *(LAS u32x4*)(lds + (buf) * STAGE + row * KPITCH + 16 * cp) = kst[i]; } } \
        _Pragma("unroll") for (int i = 0; i < NVI; ++i) { const int p = tid + i * NTHR; const int row = p >> 3, cp = p & 7; *(LAS u32x4*)(lds + (buf) * STAGE + KBYTES + row * VPITCH + 16 * cp) = vst[i]; } } while (0)
        f32x16 O[NRB];
#pragma unroll
        for (int rb = 0; rb < NRB; ++rb)
#pragma unroll
            for (int i = 0; i < 16; ++i) O[rb][i] = 0.f;
        float mrun = -1e30f, lrun = 0.f;
        ATT_LOAD(0); ATT_STORE(0); __syncthreads();
        const int koff = pir * KPITCH + (map * 64 + 8 * h2) * 2, voff = KBYTES + r * VPITCH + 16 * h2;
        const int qpos = q0 + r, qlo = q0, qhi = q0 + 31;
        for (int t = 0; t < SEQ / 64; ++t) {
            const int buf = t & 1;
            if (t + 1 < SEQ / 64) ATT_LOAD(t + 1);
            const LAS unsigned char* kb = lds + buf * STAGE + koff; const LAS unsigned char* vb = lds + buf * STAGE + voff;
            f32x16 st[2];
#pragma unroll
            for (int kg = 0; kg < 2; ++kg) {
#pragma unroll
                for (int i = 0; i < 16; ++i) st[kg][i] = 0.f;
#pragma unroll
                for (int ds = 0; ds < NDS; ++ds) { const bf16x8 kf = *(const LAS bf16x8*)(kb + kg * 32 * KPITCH + ds * 32); st[kg] = __builtin_amdgcn_mfma_f32_32x32x16_bf16(kf, qf[ds], st[kg], 0, 0, 0); }
            }
            if (DIFF) {
                const LAS float* L = (const LAS float*)(lds + LUT_OFF) + h * 512;
                const int k0 = 64 * t;
                if (k0 - qhi >= 91) { const float cb = L[256 + 100];
#pragma unroll
                    for (int kg = 0; kg < 2; ++kg)
#pragma unroll
                        for (int i = 0; i < 16; ++i) st[kg][i] += cb;
                } else if (qlo - (k0 + 63) >= 91) { const float cb = L[256 - 100];
#pragma unroll
                    for (int kg = 0; kg < 2; ++kg)
#pragma unroll
                        for (int i = 0; i < 16; ++i) st[kg][i] += cb;
                } else {
                    const int base = k0 + 8 * h2 - qpos + 256;
#pragma unroll
                    for (int kg = 0; kg < 2; ++kg)
#pragma unroll
                        for (int i = 0; i < 16; ++i) st[kg][i] += L[base + 32 * kg + 16 * (i >> 3) + (i & 7)];
                }
            }
            float mx = st[0][0];
#pragma unroll
            for (int i = 1; i < 16; ++i) mx = fmaxf(mx, st[0][i]);
#pragma unroll
            for (int i = 0; i < 16; ++i) mx = fmaxf(mx, st[1][i]);
            mx = fmaxf(mx, __shfl_xor(mx, 32));
            const float mnew = fmaxf(mrun, mx); const float alpha = __builtin_amdgcn_exp2f(mrun - mnew); mrun = mnew;
            float rs = 0.f;
#pragma unroll
            for (int kg = 0; kg < 2; ++kg)
#pragma unroll
                for (int i = 0; i < 16; ++i) { const float p = __builtin_amdgcn_exp2f(st[kg][i] - mnew); st[kg][i] = p; rs += p; }
            lrun = lrun * alpha + rs;
#pragma unroll
            for (int rb = 0; rb < NRB; ++rb)
#pragma unroll
                for (int i = 0; i < 16; ++i) O[rb][i] *= alpha;
            bf16x8 pf[2][2];
#pragma unroll
            for (int kg = 0; kg < 2; ++kg)
#pragma unroll
                for (int s2 = 0; s2 < 2; ++s2) { u32x4 w; w.x = cvtpk(st[kg][8 * s2 + 0], st[kg][8 * s2 + 1]); w.y = cvtpk(st[kg][8 * s2 + 2], st[kg][8 * s2 + 3]);
                    w.z = cvtpk(st[kg][8 * s2 + 4], st[kg][8 * s2 + 5]); w.w = cvtpk(st[kg][8 * s2 + 6], st[kg][8 * s2 + 7]); pf[kg][s2] = __builtin_bit_cast(bf16x8, w); }
#pragma unroll
            for (int rb = 0; rb < NRB; ++rb) {
#pragma unroll
                for (int kg = 0; kg < 2; ++kg)
#pragma unroll
                    for (int s2 = 0; s2 < 2; ++s2) { const bf16x8 vf = *(const LAS bf16x8*)(vb + rb * 32 * VPITCH + (32 * kg + 16 * s2) * 2); O[rb] = __builtin_amdgcn_mfma_f32_32x32x16_bf16(vf, pf[kg][s2], O[rb], 0, 0, 0); }
                __builtin_amdgcn_sched_barrier(0); }
            if (t + 1 < SEQ / 64) ATT_STORE(buf ^ 1);
            __syncthreads();
        }
        const float ltot = lrun + __shfl_xor(lrun, 32); const float inv = 1.0f / ltot;
        int lane_e = lane; asm volatile("" : "+v"(lane_e));
        const int r_e = lane_e & 31, h2_e = lane_e >> 5;
        if (!DIFF) {
            bf16* op = P.O + (tok0 + q0 + r_e) * DM + h * 64 + 4 * h2_e;
#pragma unroll
            for (int rb = 0; rb < NRB; ++rb)
#pragma unroll
                for (int g = 0; g < 4; ++g) { u32x2 w; w.x = cvtpk(O[rb][4 * g] * inv, O[rb][4 * g + 1] * inv); w.y = cvtpk(O[rb][4 * g + 2] * inv, O[rb][4 * g + 3] * inv); *(u32x2*)(op + 32 * rb + 8 * g) = w; }
        } else {
            LAS float* X = (LAS float*)lds;
            if (map == 1) { const float sc = inv * lam;
#pragma unroll
                for (int rb = 0; rb < NRB; ++rb)
#pragma unroll
                    for (int i = 0; i < 16; ++i) X[((wid - 4) * 64 + rb * 16 + i) * 64 + lane_e] = O[rb][i] * sc; }
            __syncthreads();
            if (map == 0) { float ss = 0.f;
#pragma unroll
                for (int rb = 0; rb < NRB; ++rb)
#pragma unroll
                    for (int i = 0; i < 16; ++i) { const float o = O[rb][i] * inv - X[(wid * 64 + rb * 16 + i) * 64 + lane_e]; O[rb][i] = o; ss += o * o; }
                ss += __shfl_xor(ss, 32);
                const float rn = (1.0f - LAM_INIT) / sqrtf(ss * (1.0f / 128.0f) + 1e-6f);
                bf16* op = P.O + (tok0 + q0 + r_e) * DM + 512 + h * 128 + 4 * h2_e;
#pragma unroll
                for (int rb = 0; rb < NRB; ++rb)
#pragma unroll
                    for (int g = 0; g < 4; ++g) { const f32x4 gn = *(const f32x4*)(P.dgain + 32 * rb + 8 * g + 4 * h2_e);
                        u32x2 w; w.x = cvtpk(O[rb][4 * g] * rn * gn[0], O[rb][4 * g + 1] * rn * gn[1]); w.y = cvtpk(O[rb][4 * g + 2] * rn * gn[2], O[rb][4 * g + 3] * rn * gn[3]); *(u32x2*)(op + 32 * rb + 8 * g) = w; }
            }
            __syncthreads();
        }
#undef ATT_LOAD
#undef ATT_STORE
    }
}

struct GlaP { const bf16 *QG, *KG, *VG; const float* ALR; const float* gate_up; const float* gate_bias; float* OF; float* OB; };
__device__ __forceinline__ void gla_unit(LAS unsigned char* lds, const GlaP& P, int unit) {
    const int tid = threadIdx.x, lane = tid & 63, wid = __builtin_amdgcn_readfirstlane(tid >> 6);
    const int b = unit >> 3, h = (unit >> 1) & 3, dir = unit & 1;
    LAS float* A = (LAS float*)lds;
    LAS float* Kk = A + 4096;
    LAS float* Qq = Kk + 4096;
    LAS float* Vv = Qq + 4096;
    LAS float* GU = Vv + 8192;
    LAS float* GB = GU + 1024;
    LAS float* AL = GB + 64;
    const int j = 16 * wid + (lane & 15), qd = lane >> 4;
    float S[16];
#pragma unroll
    for (int i = 0; i < 16; ++i) S[i] = 0.f;
    for (int i = tid; i < 1024; i += NTHR) { const int rr = i >> 6, ii = i & 63; GU[i] = P.gate_up[(size_t)(dir * 16 + rr) * 256 + h * 64 + ii]; }
    if (tid < 64) GB[tid] = P.gate_bias[dir * 256 + h * 64 + tid];
    float* OUT = dir ? P.OB : P.OF;
    const size_t tok0 = (size_t)b * SEQ;
    for (int c = 0; c < SEQ / 64; ++c) {
        const int tb = dir ? (SEQ - 64 * (c + 1)) : 64 * c;
        __syncthreads();
        for (int i = tid; i < 4096; i += NTHR) { const int s = i >> 6, ii = i & 63; const size_t tk = tok0 + tb + s;
            Kk[i] = bf2f(P.KG[tk * 256 + h * 64 + ii]); Qq[i] = bf2f(P.QG[tk * 256 + h * 64 + ii]); }
        for (int i = tid; i < 8192; i += NTHR) { const int s = i >> 7, jj = i & 127; Vv[i] = bf2f(P.VG[(tok0 + tb + s) * 512 + h * 128 + jj]); }
        for (int i = tid; i < 1024; i += NTHR) { const int s = i >> 4, rr = i & 15; AL[i] = P.ALR[(tok0 + tb + s) * 32 + dir * 16 + rr]; }
        __syncthreads();
        for (int i = tid; i < 4096; i += NTHR) { const int s = i >> 6, ii = i & 63; float x = GB[ii];
#pragma unroll
            for (int rr = 0; rr < 16; ++rr) x += AL[s * 16 + rr] * GU[rr * 64 + ii];
            const float ls = fminf(x, 0.f) - log1pf(__expf(-fabsf(x)));
            A[i] = __expf(ls * (1.0f / 16.0f)); }
        __syncthreads();
        for (int step = 0; step < 64; ++step) {
            const int s = dir ? 63 - step : step;
            const float v = Vv[s * 128 + j]; float o = 0.f;
            const LAS f32x4* a4 = (const LAS f32x4*)(A + s * 64 + 16 * qd); const LAS f32x4* k4 = (const LAS f32x4*)(Kk + s * 64 + 16 * qd); const LAS f32x4* q4 = (const LAS f32x4*)(Qq + s * 64 + 16 * qd);
#pragma unroll
            for (int g = 0; g < 4; ++g) { const f32x4 aa = a4[g], kk = k4[g], qq = q4[g];
#pragma unroll
                for (int e = 0; e < 4; ++e) { const float sn = aa[e] * S[4 * g + e] + kk[e] * v; S[4 * g + e] = sn; o += qq[e] * sn; } }
            o += __shfl_xor(o, 16); o += __shfl_xor(o, 32);
            if (qd == 0) OUT[(tok0 + tb + s) * 512 + h * 128 + j] = o;
        }
    }
    __syncthreads();
}

#ifndef MK_PER_PHASE
#define MK_PER_PHASE 0
#endif
constexpr int NPHASE = 21;
struct Args { const float* in[24]; float* out; unsigned char* ws; int ph_lo, ph_hi; };
static_assert(sizeof(Args) == 24 * 8 + 8 + 8 + 8, "Args has no padding");
enum { I_X = 0, I_RELB, I_EWIN, I_GUP, I_GBIAS, I_GLAGAIN, I_DLAM, I_DGAIN, I_EWOUT, I_FG, I_FU, I_FD, I_OWIN, I_QGAIN, I_KVGAIN, I_WUQ, I_WUKV, I_OWOUT, I_ROUTER, I_MG, I_MU, I_MD, I_LNG, I_LNB };

__global__ void __launch_bounds__(NTHR, 2) mega_fwd(Args args) {
    extern __shared__ __attribute__((aligned(16))) unsigned char lds_raw[];
    LAS unsigned char* lds = (LAS unsigned char*)lds_raw;
    volatile LAS unsigned* MISC = (volatile LAS unsigned*)(lds + MISC_OFF);
    const int tid = threadIdx.x, lane = tid & 63, wave = __builtin_amdgcn_readfirstlane(tid >> 6);
    const int G = gridDim.x, bx = blockIdx.x;
    const int vcu = (G % 8 == 0) ? (bx % 8) * (G / 8) + bx / 8 : bx;
    const int gw = vcu * NWAVES + wave, NGW = G * NWAVES;
    unsigned char* ws = args.ws;
    for (int u = tid; u < (LDS_BYTES - LDSCTL_OFF) / 4; u += NTHR) ((LAS unsigned*)(lds + LDSCTL_OFF))[u] = 0u;
    __syncthreads();
    const int lo = args.ph_lo, hi = args.ph_hi;
    XcdBarrier bar; bar.bar = (unsigned*)(ws + WS_CTL) + CW_BAR; bar.x = 0; bar.st = nullptr;
    if (hi - lo > 1) bar = xcd_barrier_post((unsigned*)(ws + WS_CTL) + CW_BAR, MISC + 8);
#ifdef ONLY_PHASE
#define IN(k) ((k) == ONLY_PHASE && lo <= (k) && (k) < hi)
#else
#define IN(k) (lo <= (k) && (k) < hi)
#endif
#define SEAM(k) do { if (IN(k) && IN((k) + 1)) xcd_barrier(bar); } while (0)

    const float* x_in = args.in[I_X];
    const float* ln_g = args.in[I_LNG]; const float* ln_b = args.in[I_LNB];
    float* XF = args.out;
    bf16* W_EIN = (bf16*)(ws + WS_W_EIN); bf16* W_EOUT = (bf16*)(ws + WS_W_EOUT); bf16* W_FGU = (bf16*)(ws + WS_W_FGU); bf16* W_FDN = (bf16*)(ws + WS_W_FDN);
    bf16* W_OIN = (bf16*)(ws + WS_W_OIN); bf16* W_UQ = (bf16*)(ws + WS_W_UQ); bf16* W_UKV = (bf16*)(ws + WS_W_UKV); bf16* W_OOUT = (bf16*)(ws + WS_W_OOUT);
    bf16* W_MGU = (bf16*)(ws + WS_W_MGU); bf16* W_MDN = (bf16*)(ws + WS_W_MDN);
    float* ROPE = (float*)(ws + WS_ROPE); float* LUT = (float*)(ws + WS_LUT);
    int* TOKE = (int*)(ws + WS_TOKE); float* TOKW = (float*)(ws + WS_TOKW); int* POS = (int*)(ws + WS_POS); int* BLKCNT = (int*)(ws + WS_BLKCNT); int* TILEE = (int*)(ws + WS_TILEE);
    bf16* XB = (bf16*)(ws + WS_XB);
    bf16* QG = (bf16*)(ws + WS_QG); bf16* KG = (bf16*)(ws + WS_KG); bf16* VG = (bf16*)(ws + WS_VG); bf16* GG = (bf16*)(ws + WS_GG);
    bf16* QD = (bf16*)(ws + WS_QD); bf16* KD = (bf16*)(ws + WS_KD); bf16* VDT = (bf16*)(ws + WS_VDT); float* ALR = (float*)(ws + WS_ALR);
    float* OFb = (float*)(ws + WS_OF); float* OBb = (float*)(ws + WS_OB); bf16* AO = (bf16*)(ws + WS_AO);
    bf16* Hb = (bf16*)(ws + WS_H);
    float* CQ = (float*)(ws + WS_CQ); float* CKV = (float*)(ws + WS_CKV); float* KR = (float*)(ws + WS_KR); bf16* CQN = (bf16*)(ws + WS_CQN); bf16* CKVN = (bf16*)(ws + WS_CKVN);
    bf16* Qb = (bf16*)(ws + WS_Q); bf16* Kb = (bf16*)(ws + WS_K); bf16* VTb = (bf16*)(ws + WS_VT); bf16* AO2 = (bf16*)(ws + WS_AO2);
    bf16* XP = (bf16*)(ws + WS_XP); bf16* HP = (bf16*)(ws + WS_HP);

    if (IN(0)) {
        LAS float* scr = (LAS float*)(lds + wave * 16384);
        int off = 0;
#define TRM(MODE, W, K, N, WT, ROFF) do { const int nit_ = ((K) / 64) * ((N) / 32); int g0_ = (gw - off) % NGW; if (g0_ < 0) g0_ += NGW; tr_matrix<MODE>((W), (K), (N), (WT), (ROFF), scr, g0_, NGW, lane); off = (off + nit_) % NGW; } while (0)
        TRM(1, args.in[I_EWIN], 1024, EIN_SRC, W_EIN, 0);
        TRM(0, args.in[I_EWOUT], 1024, 1024, W_EOUT, 0);
        TRM(2, args.in[I_FG], 1024, FF, W_FGU, 0);
        TRM(3, args.in[I_FU], 1024, FF, W_FGU, 0);
        TRM(0, args.in[I_FD], FF, 1024, W_FDN, 0);
        TRM(0, args.in[I_OWIN], 1024, OIN_SRC, W_OIN, 0);
        TRM(0, args.in[I_WUQ], 256, UQ_N, W_UQ, 0);
        TRM(0, args.in[I_WUKV], 128, UKV_N, W_UKV, 0);
        TRM(0, args.in[I_OWOUT], 1024, 1024, W_OOUT, 0);
        for (int e = 0; e < NEXP; ++e) {
            TRM(2, args.in[I_MG] + (size_t)e * 1024 * FF, 1024, FF, W_MGU, e * FGU_N);
            TRM(3, args.in[I_MU] + (size_t)e * 1024 * FF, 1024, FF, W_MGU, e * FGU_N);
            TRM(0, args.in[I_MD] + (size_t)e * FF * 1024, FF, 1024, W_MDN, e * 1024);
        }
#undef TRM
        for (int m = gw; m < MTOK; m += NGW) row_to_bf16(x_in + (size_t)m * DM, XB + (size_t)m * DM, lane);
        const int gt = bx * NTHR + tid, NGT = G * NTHR;
        for (int i = gt; i < SEQ * 16; i += NGT) { const int pos = i >> 4, k = i & 15; const float inv = (float)pow(10000.0, -(double)k / 16.0); const float ang = (float)pos * inv;
            ROPE[2 * i] = (float)cos((double)ang); ROPE[2 * i + 1] = (float)sin((double)ang); }
        for (int i = gt; i < 4 * 512; i += NGT) { const int h = i >> 9, rel = (i & 511) - 256; const int n = rel < 0 ? -rel : rel; int bk = rel > 0 ? 16 : 0;
            int nl = n; if (n >= 8) { nl = 8 + (31 - __clz(n * n)) - 6; if (nl > 15) nl = 15; }
            bk += nl; LUT[i] = args.in[I_RELB][bk * 4 + h] * LOG2E; }
    }
    SEAM(0);
    if (IN(1)) {
        pg8::Gemm g{XB, W_EIN, MTOK, EIN_N, DM}; pg8::StaticOrder S; S.init(MTOK, EIN_N, G, bx);
        pg8::EpiEvenIn E{QG, KG, VG, GG, QD, KD, VDT, ALR};
        pg8::gemm_phase<pg8::EpiEvenIn, pg8::StaticOrder, true, true>(lds, g, S, E);
    }
    SEAM(1);
    if (IN(2)) {
        const GlaP GP{QG, KG, VG, ALR, args.in[I_GUP], args.in[I_GBIAS], OFb, OBb};
#ifndef SKIP_GLA
        for (int u = bx; u < 64; u += G) gla_unit(lds, GP, u);
#endif
        __syncthreads();
        const AttnP AP{QD, KD, VDT, AO, LUT, args.in[I_DLAM], args.in[I_DGAIN]};
#ifndef SKIP_DIFF
        attn_phase<true>(lds, AP, G, bx);
#endif
    }
    SEAM(2);
    if (IN(3)) {
        const float* ggain = args.in[I_GLAGAIN];
        for (int m = gw; m < MTOK; m += NGW) {
            const int hh = lane >> 4, c8 = (lane & 15) * 8; const size_t o = (size_t)m * 512 + hh * 128 + c8;
            const f32x4 a0 = *(const f32x4*)(OFb + o), a1 = *(const f32x4*)(OFb + o + 4), b0 = *(const f32x4*)(OBb + o), b1 = *(const f32x4*)(OBb + o + 4);
            const f32x4 v0 = a0 + b0, v1 = a1 + b1;
            float ss = (v0.x * v0.x + v0.y * v0.y) + (v0.z * v0.z + v0.w * v0.w) + (v1.x * v1.x + v1.y * v1.y) + (v1.z * v1.z + v1.w * v1.w);
            ss += __shfl_xor(ss, 1); ss += __shfl_xor(ss, 2); ss += __shfl_xor(ss, 4); ss += __shfl_xor(ss, 8);
            const float rn = 1.0f / sqrtf(ss * (1.0f / 128.0f) + 1e-6f);
            const f32x4 g0 = *(const f32x4*)(ggain + c8), g1 = *(const f32x4*)(ggain + c8 + 4);
            const u32x4 gr = *(const u32x4*)(GG + o);
            float gt8[8];
#pragma unroll
            for (int e = 0; e < 4; ++e) { gt8[2 * e] = __builtin_bit_cast(float, gr[e] << 16); gt8[2 * e + 1] = __builtin_bit_cast(float, gr[e] & 0xffff0000u); }
            f32x4 r0, r1;
#pragma unroll
            for (int e = 0; e < 4; ++e) { r0[e] = v0[e] * rn * g0[e] * pg8::silu_f(gt8[e]); r1[e] = v1[e] * rn * g1[e] * pg8::silu_f(gt8[4 + e]); }
            u32x4 w; w.x = pk2(r0[0], r0[1]); w.y = pk2(r0[2], r0[3]); w.z = pk2(r1[0], r1[1]); w.w = pk2(r1[2], r1[3]);
            *(u32x4*)(AO + (size_t)m * DM + hh * 128 + c8) = w;
        }
    }
    SEAM(3);
    if (IN(4)) {
        pg8::Gemm g{AO, W_EOUT, MTOK, DM, DM}; pg8::StaticOrder S; S.init(MTOK, DM, G, bx);
        pg8::EpiResid E{x_in, XF, ALPHA};
        pg8::gemm_phase<pg8::EpiResid, pg8::StaticOrder, true, true>(lds, g, S, E);
    }
    SEAM(4);
    if (IN(5)) {
        for (int m = gw; m < MTOK; m += NGW) { f32x4 v[4];
#pragma unroll
            for (int j = 0; j < 4; ++j) v[j] = *((const f32x4*)(XF + (size_t)m * DM) + lane + 64 * j);
            ln_apply(v, ln_g + 0 * DM, ln_b + 0 * DM, lane); store_row_f32_bf16(v, XF + (size_t)m * DM, XB + (size_t)m * DM, lane); }
    }
    SEAM(5);
    if (IN(6)) {
        pg8::Gemm g{XB, W_FGU, MTOK, FGU_N, DM}; pg8::StaticOrder S; S.init(MTOK, FGU_N, G, bx);
        pg8::EpiSwiglu E{Hb, FGU_N / 256, 0};
        pg8::gemm_phase<pg8::EpiSwiglu, pg8::StaticOrder, true, true>(lds, g, S, E);
    }
    SEAM(6);
    if (IN(7)) {
        pg8::Gemm g{Hb, W_FDN, MTOK, DM, FF}; pg8::StaticOrder S; S.init(MTOK, DM, G, bx);
        pg8::EpiResid E{XF, XF, ALPHA};
        pg8::gemm_phase<pg8::EpiResid, pg8::StaticOrder, true, true>(lds, g, S, E);
    }
    SEAM(7);
    if (IN(8)) {
        for (int m = gw; m < MTOK; m += NGW) { f32x4 v[4];
#pragma unroll
            for (int j = 0; j < 4; ++j) v[j] = *((const f32x4*)(XF + (size_t)m * DM) + lane + 64 * j);
            ln_apply(v, ln_g + 1 * DM, ln_b + 1 * DM, lane); store_row_f32_bf16(v, XF + (size_t)m * DM, XB + (size_t)m * DM, lane); }
    }
    SEAM(8);
    if (IN(9)) {
        pg8::Gemm g{XB, W_OIN, MTOK, OIN_N, DM}; pg8::StaticOrder S; S.init(MTOK, OIN_N, G, bx);
        pg8::EpiOddIn E{CQ, CKV, KR};
        pg8::gemm_phase<pg8::EpiOddIn, pg8::StaticOrder, true, true>(lds, g, S, E);
    }
    SEAM(9);
    if (IN(10)) {
        const float* qg = args.in[I_QGAIN]; const float* kg = args.in[I_KVGAIN];
        for (int m = gw; m < MTOK; m += NGW) {
            const f32x4 cq = *((const f32x4*)(CQ + (size_t)m * 256) + lane);
            float ss = wave_sum((cq.x * cq.x + cq.y * cq.y) + (cq.z * cq.z + cq.w * cq.w));
            float rn = 1.0f / sqrtf(ss * (1.0f / 256.0f) + 1e-6f);
            const f32x4 g4 = *((const f32x4*)qg + lane);
            u32x2 w; w.x = pk2(cq.x * rn * g4.x, cq.y * rn * g4.y); w.y = pk2(cq.z * rn * g4.z, cq.w * rn * g4.w);
            *((u32x2*)(CQN + (size_t)m * 256) + lane) = w;
            const f32x2 ck = *((const f32x2*)(CKV + (size_t)m * 128) + lane);
            ss = wave_sum(ck.x * ck.x + ck.y * ck.y); rn = 1.0f / sqrtf(ss * (1.0f / 128.0f) + 1e-6f);
            const f32x2 g2 = *((const f32x2*)kg + lane);
            *((unsigned*)(CKVN + (size_t)m * 128) + lane) = pk2(ck.x * rn * g2.x, ck.y * rn * g2.y);
            const float val = KR[(size_t)m * 32 + (lane & 31)]; const float partner = __shfl_xor(val, 16);
            const int pos = m & (SEQ - 1), i = lane & 15; const float cs = ROPE[(pos * 16 + i) * 2], sn = ROPE[(pos * 16 + i) * 2 + 1];
            const float o = (lane & 16) ? (partner * sn + val * cs) : (val * cs - partner * sn);
            if (lane < 32) { const bf16 ob = (bf16)f2bf(o); bf16* kp = Kb + (size_t)m * 1536 + 64 + lane;
#pragma unroll
                for (int h = 0; h < 16; ++h) kp[h * 96] = ob; }
        }
    }
    SEAM(10);
    if (IN(11)) {
#ifndef SKIP_QUP
        { int kq = 256; asm volatile("" : "+s"(kq)); pg8::Gemm g{CQN, W_UQ, MTOK, UQ_N, kq}; pg8::StaticOrder S; S.init(MTOK, UQ_N, G, bx);
          pg8::EpiQUp E{Qb, ROPE, 0.10206207261596575f * LOG2E};
          pg8::gemm_phase<pg8::EpiQUp, pg8::StaticOrder, true, true>(lds, g, S, E); }
#endif
        __syncthreads();
#ifndef SKIP_KVUP
        { int kk = 128; asm volatile("" : "+s"(kk)); pg8::Gemm g{CKVN, W_UKV, MTOK, UKV_N, kk}; pg8::StaticOrder S; S.init(MTOK, UKV_N, G, bx);
          pg8::EpiKvUp E{Kb, VTb};
          pg8::gemm_phase<pg8::EpiKvUp, pg8::StaticOrder, true, true>(lds, g, S, E); }
#endif
    }
    SEAM(11);
    if (IN(12)) {
        const AttnP AP{Qb, Kb, VTb, AO2, nullptr, nullptr, nullptr};
        attn_phase<false>(lds, AP, G, bx);
    }
    SEAM(12);
    if (IN(13)) {
        pg8::Gemm g{AO2, W_OOUT, MTOK, DM, DM}; pg8::StaticOrder S; S.init(MTOK, DM, G, bx);
        pg8::EpiResid E{XF, XF, ALPHA};
        pg8::gemm_phase<pg8::EpiResid, pg8::StaticOrder, true, true>(lds, g, S, E);
    }
    SEAM(13);
    if (IN(14)) {
        LAS int* cntL = (LAS int*)lds; const float* rw = args.in[I_ROUTER];
        for (int ch = bx; ch < MTOK / 64; ch += G) {
            if (tid < 8) cntL[tid] = 0;
            __syncthreads();
            for (int i = 0; i < 8; ++i) { const int m = 64 * ch + 8 * wave + i; f32x4 v[4];
#pragma unroll
                for (int j = 0; j < 4; ++j) v[j] = *((const f32x4*)(XF + (size_t)m * DM) + lane + 64 * j);
                ln_apply(v, ln_g + 2 * DM, ln_b + 2 * DM, lane); store_row_f32_bf16(v, XF + (size_t)m * DM, XB + (size_t)m * DM, lane);
                float lg[8];
#pragma unroll
                for (int e = 0; e < 8; ++e) lg[e] = 0.f;
#pragma unroll
                for (int j = 0; j < 4; ++j)
#pragma unroll
                    for (int e4 = 0; e4 < 4; ++e4) { const int d = 256 * j + 4 * lane + e4; const f32x4 r0 = *(const f32x4*)(rw + (size_t)d * 8), r1 = *(const f32x4*)(rw + (size_t)d * 8 + 4); const float xv = v[j][e4];
#pragma unroll
                        for (int e = 0; e < 4; ++e) { lg[e] += xv * r0[e]; lg[4 + e] += xv * r1[e]; } }
#pragma unroll
                for (int e = 0; e < 8; ++e) lg[e] = wave_sum(lg[e]);
                int e0 = 0; float v0 = lg[0];
#pragma unroll
                for (int e = 1; e < 8; ++e) if (lg[e] > v0) { v0 = lg[e]; e0 = e; }
                int e1 = -1; float v1 = -3.0e38f;
#pragma unroll
                for (int e = 0; e < 8; ++e) if (e != e0 && lg[e] > v1) { v1 = lg[e]; e1 = e; }
                const float w0 = 1.0f / (1.0f + __expf(v1 - v0)), w1 = 1.0f - w0;
                if (lane == 0) { TOKE[2 * m] = e0; TOKE[2 * m + 1] = e1; TOKW[2 * m] = w0; TOKW[2 * m + 1] = w1; atomicAdd((int*)(cntL + e0), 1); atomicAdd((int*)(cntL + e1), 1); }
            }
            __syncthreads();
            if (tid < 8) BLKCNT[ch * 8 + tid] = cntL[tid];
            __syncthreads();
        }
    }
    SEAM(14);
    if (IN(15)) {
        LAS int* cnt_all = (LAS int*)lds; LAS int* pre = cnt_all + 2048; LAS int* segb = pre + 8; LAS int* w0cnt = segb + 8; LAS int* posL = w0cnt + 8; LAS int* tot = posL + 128;
        for (int i = tid; i < 2048; i += NTHR) cnt_all[i] = BLKCNT[i];
        __syncthreads();
        if (tid < 8) { int s = 0; for (int c2 = 0; c2 < 256; ++c2) s += cnt_all[c2 * 8 + tid]; tot[tid] = s; }
        __syncthreads();
        if (tid == 0) { int rowb = 0; for (int e = 0; e < 8; ++e) { segb[e] = rowb; rowb += ((tot[e] + 255) >> 8) << 8; }
            if (bx == 0) { int t = 0; for (int e = 0; e < 8; ++e) { const int nt = (tot[e] + 255) >> 8; for (int k = 0; k < nt; ++k) TILEE[t++] = e; } TILEE[MAXT] = t; } }
        __syncthreads();
        for (int ch = bx; ch < MTOK / 64; ch += G) {
            if (tid < 8) { int s = 0; for (int c2 = 0; c2 < ch; ++c2) s += cnt_all[c2 * 8 + tid]; pre[tid] = s; }
            int e_mine = -1, rank = 0, token = 0, kk = 0;
            if (tid < 128) { token = 64 * ch + (tid >> 1); kk = tid & 1; e_mine = TOKE[2 * token + kk]; }
            if (wave < 2) {
#pragma unroll
                for (int e = 0; e < 8; ++e) { const unsigned long long mask = __ballot(e_mine == e); if (e_mine == e) rank = __popcll(mask & ((1ull << lane) - 1ull)); if (wave == 0 && lane == 0) w0cnt[e] = __popcll(mask); }
            }
            __syncthreads();
            if (tid < 128) { if (wave == 1) rank += w0cnt[e_mine]; const int pos = segb[e_mine] + pre[e_mine] + rank; posL[tid] = pos; POS[2 * token + kk] = pos; }
            __syncthreads();
            for (int en = wave; en < 128; en += 8) { const int tk = 64 * ch + (en >> 1); const int pos = posL[en];
                const u32x4* src = (const u32x4*)(XB + (size_t)tk * DM); u32x4* dst = (u32x4*)(XP + (size_t)pos * DM);
                const u32x4 a = src[lane], b2 = src[lane + 64]; dst[lane] = a; dst[lane + 64] = b2; }
            __syncthreads();
        }
    }
    SEAM(15);
#define MOE_GU(ph, PASS) if (IN(ph)) { const int T = TILEE[MAXT], T1 = (T + 1) >> 1; const int t0 = (PASS) ? T1 : 0, t1 = (PASS) ? T : T1; \
        pg8::Gemm g{XP, W_MGU, 0, 0, DM}; pg8::MoeOrder S{t0, t1, FGU_N / 256, G, bx, FGU_N / 256, 0, TILEE}; pg8::EpiSwiglu E{HP, FGU_N / 256, t0}; \
        pg8::gemm_phase<pg8::EpiSwiglu, pg8::MoeOrder, true, true>(lds, g, S, E); }
#define MOE_DN(ph, PASS) if (IN(ph)) { const int T = TILEE[MAXT], T1 = (T + 1) >> 1; const int t0 = (PASS) ? T1 : 0, t1 = (PASS) ? T : T1; \
        pg8::Gemm g{HP, W_MDN, 0, 0, FF}; pg8::MoeOrder S{t0, t1, 4, G, bx, 4, t0, TILEE}; pg8::EpiBf16Out E{XP, t0}; \
        pg8::gemm_phase<pg8::EpiBf16Out, pg8::MoeOrder, true, true>(lds, g, S, E); }
    MOE_GU(16, 0) SEAM(16);
    MOE_DN(17, 0) SEAM(17);
    MOE_GU(18, 1) SEAM(18);
    MOE_DN(19, 1) SEAM(19);
    if (IN(20)) {
        for (int m = gw; m < MTOK; m += NGW) {
            const int p0 = POS[2 * m], p1 = POS[2 * m + 1]; const float w0 = TOKW[2 * m], w1 = TOKW[2 * m + 1];
            f32x4 v[4];
#pragma unroll
            for (int j = 0; j < 4; ++j) { const f32x4 xv = *((const f32x4*)(XF + (size_t)m * DM) + lane + 64 * j);
                const u32x2 y0 = *((const u32x2*)(XP + (size_t)p0 * DM) + lane + 64 * j), y1 = *((const u32x2*)(XP + (size_t)p1 * DM) + lane + 64 * j);
                f32x4 a, b2; a.x = __builtin_bit_cast(float, y0.x << 16); a.y = __builtin_bit_cast(float, y0.x & 0xffff0000u); a.z = __builtin_bit_cast(float, y0.y << 16); a.w = __builtin_bit_cast(float, y0.y & 0xffff0000u);
                b2.x = __builtin_bit_cast(float, y1.x << 16); b2.y = __builtin_bit_cast(float, y1.x & 0xffff0000u); b2.z = __builtin_bit_cast(float, y1.y << 16); b2.w = __builtin_bit_cast(float, y1.y & 0xffff0000u);
                v[j] = xv * ALPHA + a * w0 + b2 * w1; }
            ln_apply(v, ln_g + 3 * DM, ln_b + 3 * DM, lane);
            GAS f32x4* fr = (GAS f32x4*)(XF + (size_t)m * DM) + lane;
#pragma unroll
            for (int j = 0; j < 4; ++j) fr[64 * j] = v[j];
        }
    }
#undef IN
#undef SEAM
}

extern "C" void kernel_launch(void* const* d_in, const int* in_sizes, int n_in, void* d_out, int out_size, void* d_ws, size_t ws_size, hipStream_t stream) {
    static int grid = 0;
    if (grid == 0) {
        if (n_in != 24 || out_size != MTOK * DM || ws_size < WS_END) { fprintf(stderr, "kernel_launch: unexpected problem (n_in %d, out %d, ws %zu)\n", n_in, out_size, ws_size); grid = -1; return; }
        int dev = 0, cus = 0, per_cu = 0;
        if (hipGetDevice(&dev) != hipSuccess || hipDeviceGetAttribute(&cus, hipDeviceAttributeMultiprocessorCount, dev) != hipSuccess) { grid = -1; return; }
        if (hipFuncSetAttribute((const void*)mega_fwd, hipFuncAttributeMaxDynamicSharedMemorySize, LDS_BYTES) != hipSuccess) { fprintf(stderr, "kernel_launch: hipFuncSetAttribute failed\n"); grid = -1; return; }
        if (hipOccupancyMaxActiveBlocksPerMultiprocessor(&per_cu, (const void*)mega_fwd, NTHR, LDS_BYTES) != hipSuccess || per_cu < 1) { fprintf(stderr, "kernel_launch: occupancy query says %d\n", per_cu); }
        (void)hipGetLastError();
        grid = cus;
    }
    if (grid < 0) return;
    if (hipMemsetAsync((char*)d_ws + WS_CTL, 0, CTL_ZERO_BYTES, stream) != hipSuccess) return;
    Args a{};
    for (int i = 0; i < 24; ++i) a.in[i] = (const float*)d_in[i];
    a.out = (float*)d_out; a.ws = (unsigned char*)d_ws;
#if MK_PER_PHASE
    for (int p = 0; p < NPHASE; ++p) { a.ph_lo = p; a.ph_hi = p + 1; hipLaunchKernelGGL(mega_fwd, dim3(grid), dim3(NTHR), LDS_BYTES, stream, a); }
#else
    a.ph_lo = 0; a.ph_hi = NPHASE; hipLaunchKernelGGL(mega_fwd, dim3(grid), dim3(NTHR), LDS_BYTES, stream, a);
#endif
}
```

```cpp
#include <hip/hip_runtime.h>
#include <cstdio>
#include <cstdint>
namespace pg8 {
#define PG8_LAS __attribute__((address_space(3)))
typedef unsigned short bf16_t;
typedef short bf16x8 __attribute__((ext_vector_type(8)));
typedef float f32x4 __attribute__((ext_vector_type(4)));
typedef unsigned u32x4 __attribute__((ext_vector_type(4)));
constexpr int BM = 256, BK = 64, HALF = 128, HTB = HALF * BK * 2  , STAGE_BYTES = 8 * HTB, NXCD = 8, WGM = 8;

__host__ __device__ __forceinline__ int lds_byte(int r, int c) { const int st = (r >> 4) * 2 + (c >> 5), rr = r & 15, cc = c & 31, ob = rr * 64 + cc * 2; return st * 1024 + (ob ^ (((ob >> 9) & 1) << 5)); }
__host__ __device__ __forceinline__ void stage_rc(int b, int& R, int& C) { const int st = b / 1024, sb = b % 1024, swz = sb ^ (((sb >> 9) & 1) << 5); R = (st >> 1) * 16 + swz / 64; C = (st & 1) * 32 + (swz % 64) / 2; }
__host__ __device__ __forceinline__ int perm32(int rho) { const int n = rho >> 4, i = rho & 15; return 8 * (i >> 2) + 4 * n + (i & 3); }

struct Unit { int pm, pn; };
struct Gemm { const bf16_t* A; const bf16_t* Bt; int M, N, K; };

struct StaticOrder {
    int nM, nN, nwg, G, c;
    __host__ __device__ void init(int M, int N, int G_, int c_) { nM = M / BM; nN = N / BM; nwg = nM * nN; G = G_; c = c_; }
    __host__ __device__ bool next(int i, Unit& u) const {
        const long L = (long)i * G + c; if (L >= nwg) return false;
        int wgid = (int)L; { const int q = nwg / NXCD, r = nwg % NXCD, xcd = wgid % NXCD, off = wgid / NXCD; wgid = (xcd < r ? xcd * (q + 1) : r * (q + 1) + (xcd - r) * q) + off; }
        const int nig = WGM * nN, gid = wgid / nig, fm = gid * WGM, gsz = (nM - fm) < WGM ? (nM - fm) : WGM;
        u.pm = fm + ((wgid % nig) % gsz); u.pn = (wgid % nig) / gsz; return true;
    }
    __device__ __forceinline__ void a_ready(const Unit&) const {}
    __device__ __forceinline__ void done(const Unit&) const {}
};

__device__ __forceinline__ unsigned cvt_pk_bf16(float lo, float hi) { unsigned r; asm volatile("v_cvt_pk_bf16_f32 %0, %1, %2" : "=v"(r) : "v"(lo), "v"(hi)); return r; }
typedef float f32x2 __attribute__((ext_vector_type(2)));
typedef unsigned u32x2 __attribute__((ext_vector_type(2)));
__device__ __forceinline__ unsigned f2bf_rne(float f) { unsigned u = __builtin_bit_cast(unsigned, f); return (u + 0x7fffu + ((u >> 16) & 1u)) >> 16; }
__device__ __forceinline__ float silu_f(float g) { return g * __builtin_amdgcn_rcpf(1.0f + __expf(-g)); }
__device__ __forceinline__ u32x4 pack8(const f32x4 v0, const f32x4 v1) { u32x4 w; w.x = cvt_pk_bf16(v0[0], v0[1]); w.y = cvt_pk_bf16(v0[2], v0[3]); w.z = cvt_pk_bf16(v1[0], v1[1]); w.w = cvt_pk_bf16(v1[2], v1[3]); return w; }

struct EpiEvenIn {
    static constexpr bool PERM = true, AFTER_DRAIN = false;
    bf16_t *QG, *KG, *VGT, *GG, *QD, *KD, *VDT; float* ALR;
    __device__ __forceinline__ void operator()(const f32x4 (&acc)[2][2][4][2], const Unit& u, int wr, int wc, int fr, int fq) const {
        const int pn = u.pn; const int row0 = u.pm * BM + wr * 64 + fr; const int cl = wc * 32 + 8 * fq;
        if (pn < 10 && (pn & ~1) != 2) {
            bf16_t* base; int ld, c0; float sc = 1.f;
            if (pn == 0) { base = QG; ld = 256; c0 = 0; sc = 0.125f; }
            else if (pn == 1) { base = KG; ld = 256; c0 = 0; }
            else if (pn < 6) { base = GG; ld = 512; c0 = (pn - 4) * 256; }
            else if (pn < 8) { base = QD; ld = 512; c0 = (pn - 6) * 256; sc = 0.125f * 1.4426950408889634f; }
            else { base = KD; ld = 512; c0 = (pn - 8) * 256; }
#pragma unroll
            for (int ai = 0; ai < 2; ++ai)
#pragma unroll
                for (int m = 0; m < 4; ++m) { bf16_t* rowp = base + (size_t)(row0 + ai * HALF + m * 16) * ld + c0 + cl;
#pragma unroll
                    for (int bj = 0; bj < 2; ++bj) *(u32x4*)(rowp + bj * HALF) = pack8(acc[ai][bj][m][0] * sc, acc[ai][bj][m][1] * sc); }
        } else if (pn < 12) {
            const int b = row0 >> 11, s0 = row0 & 2047;
            bf16_t* vbase = pn < 4 ? VGT : VDT; const int hb = pn < 4 ? 2 * (pn - 2) : 2 * (pn - 10);
#pragma unroll
            for (int bj = 0; bj < 2; ++bj) { bf16_t* vp0 = vbase + ((size_t)(b * 4 + hb + bj) * 128 + cl) * 2048 + s0;
#pragma unroll
                for (int n = 0; n < 2; ++n)
#pragma unroll
                    for (int e = 0; e < 4; ++e) { bf16_t* vp = vp0 + (size_t)(4 * n + e) * 2048;
#pragma unroll
                        for (int ai = 0; ai < 2; ++ai)
#pragma unroll
                            for (int m = 0; m < 4; ++m) vp[ai * HALF + m * 16] = (bf16_t)f2bf_rne(acc[ai][bj][m][n][e]); } }
        } else {
            if (wc == 0) {
#pragma unroll
                for (int ai = 0; ai < 2; ++ai)
#pragma unroll
                    for (int m = 0; m < 4; ++m) { float* rowp = ALR + (size_t)(row0 + ai * HALF + m * 16) * 32 + 8 * fq; *(f32x4*)rowp = acc[ai][0][m][0]; *(f32x4*)(rowp + 4) = acc[ai][0][m][1]; }
            }
        }
    }
};
struct EpiResid {
    static constexpr bool PERM = false, AFTER_DRAIN = false;
    const float* base; float* out; float alpha;
    __device__ __forceinline__ void operator()(const f32x4 (&acc)[2][2][4][2], const Unit& u, int wr, int wc, int fr, int fq) const {
        const int col0 = u.pn * BM + wc * 32 + 4 * fq;
#pragma unroll
        for (int ai = 0; ai < 2; ++ai)
#pragma unroll
            for (int m = 0; m < 4; ++m) { const size_t off = (size_t)(u.pm * BM + ai * HALF + wr * 64 + m * 16 + fr) * 1024 + col0;
#pragma unroll
                for (int bj = 0; bj < 2; ++bj)
#pragma unroll
                    for (int n = 0; n < 2; ++n) { const size_t p = off + bj * HALF + n * 16; const f32x4 bs = *(const f32x4*)(base + p); *(f32x4*)(out + p) = bs * alpha + acc[ai][bj][m][n]; } }
    }
};
struct EpiSwiglu {
    static constexpr bool PERM = true, AFTER_DRAIN = false;
    bf16_t* H; int ncol, pm_off;
    __device__ __forceinline__ void operator()(const f32x4 (&acc)[2][2][4][2], const Unit& u, int wr, int wc, int fr, int fq) const {
        const int pnl = u.pn % ncol; const int rowb = (u.pm - pm_off) * BM + wr * 64 + fr; const int col = pnl * 128 + wc * 32 + 8 * fq;
#pragma unroll
        for (int ai = 0; ai < 2; ++ai)
#pragma unroll
            for (int m = 0; m < 4; ++m) { bf16_t* rowp = H + (size_t)(rowb + ai * HALF + m * 16) * 2816 + col;
                f32x4 h0, h1;
#pragma unroll
                for (int e = 0; e < 4; ++e) { h0[e] = silu_f(acc[ai][0][m][0][e]) * acc[ai][1][m][0][e]; h1[e] = silu_f(acc[ai][0][m][1][e]) * acc[ai][1][m][1][e]; }
                *(u32x4*)rowp = pack8(h0, h1); }
    }
};
struct EpiBf16Out {
    static constexpr bool PERM = true, AFTER_DRAIN = false;
    bf16_t* Y; int pm_add;
    __device__ __forceinline__ void operator()(const f32x4 (&acc)[2][2][4][2], const Unit& u, int wr, int wc, int fr, int fq) const {
        const int pnl = u.pn & 3; const int rowb = (u.pm + pm_add) * BM + wr * 64 + fr; const int col = pnl * BM + wc * 32 + 8 * fq;
#pragma unroll
        for (int ai = 0; ai < 2; ++ai)
#pragma unroll
            for (int m = 0; m < 4; ++m) { bf16_t* rowp = Y + (size_t)(rowb + ai * HALF + m * 16) * 1024 + col;
#pragma unroll
                for (int bj = 0; bj < 2; ++bj) *(u32x4*)(rowp + bj * HALF) = pack8(acc[ai][bj][m][0], acc[ai][bj][m][1]); }
    }
};
struct EpiOddIn {
    static constexpr bool PERM = false, AFTER_DRAIN = false;
    float *CQ, *CKV, *KR;
    __device__ __forceinline__ void operator()(const f32x4 (&acc)[2][2][4][2], const Unit& u, int wr, int wc, int fr, int fq) const {
        const size_t row0 = (size_t)(u.pm * BM + wr * 64 + fr);
        if (u.pn == 0) {
#pragma unroll
            for (int ai = 0; ai < 2; ++ai)
#pragma unroll
                for (int m = 0; m < 4; ++m)
#pragma unroll
                    for (int bj = 0; bj < 2; ++bj)
#pragma unroll
                        for (int n = 0; n < 2; ++n) *(f32x4*)(CQ + (row0 + ai * HALF + m * 16) * 256 + bj * HALF + wc * 32 + n * 16 + 4 * fq) = acc[ai][bj][m][n];
        } else {
#pragma unroll
            for (int ai = 0; ai < 2; ++ai)
#pragma unroll
                for (int m = 0; m < 4; ++m)
#pragma unroll
                    for (int n = 0; n < 2; ++n) *(f32x4*)(CKV + (row0 + ai * HALF + m * 16) * 128 + wc * 32 + n * 16 + 4 * fq) = acc[ai][0][m][n];
            if (wc == 0) {
#pragma unroll
                for (int ai = 0; ai < 2; ++ai)
#pragma unroll
                    for (int m = 0; m < 4; ++m)
#pragma unroll
                        for (int n = 0; n < 2; ++n) *(f32x4*)(KR + (row0 + ai * HALF + m * 16) * 32 + n * 16 + 4 * fq) = acc[ai][1][m][n];
            }
        }
    }
};
struct EpiQUp {
    static constexpr bool PERM = false, AFTER_DRAIN = false;
    bf16_t* Q; const float* rope; float qs;
    __device__ __forceinline__ void operator()(const f32x4 (&acc)[2][2][4][2], const Unit& u, int wr, int wc, int fr, int fq) const {
        const int row0 = u.pm * BM + wr * 64 + fr;
#pragma unroll
        for (int bj = 0; bj < 2; ++bj) { const int G = u.pn * 8 + bj * 4 + wc; bf16_t* colp = Q + G * 32 + 4 * fq;
            if ((G % 3) != 2) {
#pragma unroll
                for (int ai = 0; ai < 2; ++ai)
#pragma unroll
                    for (int m = 0; m < 4; ++m) { bf16_t* rowp = colp + (size_t)(row0 + ai * HALF + m * 16) * 1536;
                        const f32x4 a0 = acc[ai][bj][m][0] * qs, a1 = acc[ai][bj][m][1] * qs;
                        u32x2 w0, w1; w0.x = cvt_pk_bf16(a0[0], a0[1]); w0.y = cvt_pk_bf16(a0[2], a0[3]); w1.x = cvt_pk_bf16(a1[0], a1[1]); w1.y = cvt_pk_bf16(a1[2], a1[3]);
                        *(u32x2*)rowp = w0; *(u32x2*)(rowp + 16) = w1; }
            } else {
#pragma unroll
                for (int ai = 0; ai < 2; ++ai)
#pragma unroll
                    for (int m = 0; m < 4; ++m) { const int row = row0 + ai * HALF + m * 16; bf16_t* rowp = colp + (size_t)row * 1536;
                        const int pos = row & 2047; const f32x4* rp = (const f32x4*)(rope + (size_t)pos * 32 + 8 * fq); const f32x4 t0 = rp[0], t1 = rp[1];
                        const f32x4 cs = (f32x4){t0[0], t0[2], t1[0], t1[2]} * qs, sn = (f32x4){t0[1], t0[3], t1[1], t1[3]} * qs;
                        const f32x4 a0 = acc[ai][bj][m][0] * cs - acc[ai][bj][m][1] * sn, a1 = acc[ai][bj][m][0] * sn + acc[ai][bj][m][1] * cs;
                        u32x2 w0, w1; w0.x = cvt_pk_bf16(a0[0], a0[1]); w0.y = cvt_pk_bf16(a0[2], a0[3]); w1.x = cvt_pk_bf16(a1[0], a1[1]); w1.y = cvt_pk_bf16(a1[2], a1[3]);
                        *(u32x2*)rowp = w0; *(u32x2*)(rowp + 16) = w1;
                        asm volatile("" ::: "memory"); }
            } }
    }
};
struct EpiKvUp {
    static constexpr bool PERM = true, AFTER_DRAIN = false;
    bf16_t *K, *VT;
    __device__ __forceinline__ void operator()(const f32x4 (&acc)[2][2][4][2], const Unit& u, int wr, int wc, int fr, int fq) const {
        const int row0 = u.pm * BM + wr * 64 + fr;
        if (wc < 2) {
#pragma unroll
            for (int bj = 0; bj < 2; ++bj) { bf16_t* colp = K + (2 * u.pn + bj) * 96 + wc * 32 + 8 * fq;
#pragma unroll
                for (int ai = 0; ai < 2; ++ai)
#pragma unroll
                    for (int m = 0; m < 4; ++m) *(u32x4*)(colp + (size_t)(row0 + ai * HALF + m * 16) * 1536) = pack8(acc[ai][bj][m][0], acc[ai][bj][m][1]); }
        } else {
            const int b = row0 >> 11, s0 = row0 & 2047;
#pragma unroll
            for (int bj = 0; bj < 2; ++bj) { bf16_t* vp0 = VT + ((size_t)(b * 16 + 2 * u.pn + bj) * 64 + (wc - 2) * 32 + 8 * fq) * 2048 + s0;
#pragma unroll
                for (int n = 0; n < 2; ++n)
#pragma unroll
                    for (int e = 0; e < 4; ++e) { bf16_t* vp = vp0 + (size_t)(4 * n + e) * 2048;
#pragma unroll
                        for (int ai = 0; ai < 2; ++ai)
#pragma unroll
                            for (int m = 0; m < 4; ++m) vp[ai * HALF + m * 16] = (bf16_t)f2bf_rne(acc[ai][bj][m][n][e]); } }
        }
    }
};
struct MoeOrder {
    int t0, t1, ncol, G, c, bstride, pm_sub; const int* tile_e;
    __device__ __forceinline__ bool next(int i, Unit& u) const {
        const int L = i * G + c; if (L >= (t1 - t0) * ncol) return false;
        const int tile = t0 + L / ncol, pn = L % ncol;
        u.pm = tile - pm_sub; u.pn = tile_e[tile] * bstride + pn; return true;
    }
    __device__ __forceinline__ void a_ready(const Unit&) const {}
    __device__ __forceinline__ void done(const Unit&) const {}
};

template <class Epi, class Sched, bool ALIGN_EPI = false, bool SP2 = false>
__device__ __forceinline__ void gemm_phase(PG8_LAS unsigned char* lds, const Gemm g, const Sched& S, const Epi& E) {
    const int tid = threadIdx.x, wid = __builtin_amdgcn_readfirstlane(tid >> 6), lane = tid & 63, wr = wid >> 2, wc = wid & 3, fr = lane & 15, fq = lane >> 4;
    const int K = g.K, nt = K / BK;
    unsigned voffA[2], voffB[2];
#pragma unroll
    for (int i = 0; i < 2; ++i) { int R, C; stage_rc(tid * 16 + i * 8192, R, C); const int Rb = Epi::PERM ? ((R & ~31) + perm32(R & 31)) : R;
        voffA[i] = (unsigned)(R * K + C) * 2u; voffB[i] = (unsigned)(Rb * K + C) * 2u; }
    const size_t kstep = (size_t)(BK * 2);
    const size_t hstep = (size_t)HALF * K * 2;
    const size_t tstep = 2 * hstep;
    const unsigned ldsw = (unsigned)wid * 1024u;
    const int aoff = lds_byte(wr * 64 + fr, fq * 8), boff = lds_byte(wc * 32 + fr, fq * 8);
#define PG8_SA(b, h) (((b) * 2 + (h)) * HTB)
#define PG8_SB(b, h) ((4 + (b) * 2 + (h)) * HTB)
#define PG8_STAGE(bufoff, gbase, voff) do { _Pragma("unroll") for (int _i = 0; _i < 2; ++_i) \
        __builtin_amdgcn_global_load_lds((const unsigned*)((const char*)(gbase) + (voff)[_i]), (PG8_LAS unsigned*)(lds + (bufoff) + ldsw + _i * 8192), 16, 0, 0); } while (0)
#define PG8_LDA(dst, b, h) do { _Pragma("unroll") for (int m = 0; m < 4; ++m) _Pragma("unroll") for (int k = 0; k < 2; ++k) dst[m][k] = *(const PG8_LAS bf16x8*)(lds + PG8_SA(b, h) + aoff + m * 2048 + k * 1024); } while (0)
#define PG8_LDB(dst, b, h) do { _Pragma("unroll") for (int n = 0; n < 2; ++n) _Pragma("unroll") for (int k = 0; k < 2; ++k) dst[n][k] = *(const PG8_LAS bf16x8*)(lds + PG8_SB(b, h) + boff + n * 2048 + k * 1024); } while (0)
#define PG8_MMA(ai, bj, At, Bt) do { __builtin_amdgcn_s_setprio(1); _Pragma("unroll") for (int m = 0; m < 4; ++m) _Pragma("unroll") for (int n = 0; n < 2; ++n) _Pragma("unroll") for (int k = 0; k < 2; ++k) \
        acc[ai][bj][m][n] = __builtin_amdgcn_mfma_f32_16x16x32_bf16(Bt[n][k], At[m][k], acc[ai][bj][m][n], 0, 0, 0); __builtin_amdgcn_s_setprio(0); } while (0)
#define PG8_WAIT_V(n) asm volatile("s_waitcnt vmcnt(" #n ")" ::: "memory")
#define PG8_WAIT_L(n) asm volatile("s_waitcnt lgkmcnt(" #n ")" ::: "memory")
#define PG8_BAR __builtin_amdgcn_s_barrier()
#define PG8_SCHED __builtin_amdgcn_sched_barrier(0)
    Unit cur, nxt; int ui = 0;
    if (!S.next(0, cur)) return;
    f32x4 acc[2][2][4][2];
#pragma unroll
    for (int a = 0; a < 2; ++a)
#pragma unroll
        for (int b = 0; b < 2; ++b)
#pragma unroll
            for (int m = 0; m < 4; ++m)
#pragma unroll
                for (int n = 0; n < 2; ++n) acc[a][b][m][n] = (f32x4){0.f, 0.f, 0.f, 0.f};
    bf16x8 At[4][2], B0[2][2], B1[2][2];
    const char* cA = (const char*)g.A + (size_t)cur.pm * tstep; const char* cB = (const char*)g.Bt + (size_t)cur.pn * tstep;
    S.a_ready(cur);
    if constexpr (SP2) {
        PG8_STAGE(PG8_SB(0, 0), cB, voffB); PG8_STAGE(PG8_SB(0, 1), cB + hstep, voffB); PG8_STAGE(PG8_SA(0, 0), cA, voffA); PG8_STAGE(PG8_SA(0, 1), cA + hstep, voffA);
        if (wr == 1) PG8_BAR;
        PG8_WAIT_V(2); PG8_BAR;
        PG8_STAGE(PG8_SB(1, 0), cB + kstep, voffB); PG8_STAGE(PG8_SA(1, 0), cA + kstep, voffA); PG8_STAGE(PG8_SB(1, 1), cB + hstep + kstep, voffB);
        PG8_WAIT_V(6); PG8_BAR;
    } else {
        PG8_STAGE(PG8_SB(0, 0), cB, voffB); PG8_STAGE(PG8_SA(0, 0), cA, voffA); PG8_STAGE(PG8_SB(0, 1), cB + hstep, voffB); PG8_STAGE(PG8_SA(0, 1), cA + hstep, voffA);
        if (wr == 1) PG8_BAR;
        PG8_WAIT_V(4); PG8_BAR;
        PG8_STAGE(PG8_SB(1, 0), cB + kstep, voffB); PG8_STAGE(PG8_SA(1, 0), cA + kstep, voffA); PG8_STAGE(PG8_SB(1, 1), cB + hstep + kstep, voffB);
        PG8_WAIT_V(6); PG8_BAR;
    }
    for (;;) {
        const bool has_next = S.next(ui + 1, nxt);
        const char* nA = has_next ? (const char*)g.A + (size_t)nxt.pm * tstep : cA; const char* nB = has_next ? (const char*)g.Bt + (size_t)nxt.pn * tstep : cB;
        for (int t = 0; t < nt; t += 2) {
            const bool last = (t == nt - 2);
            const char* a1 = cA + (size_t)(t + 1) * kstep;
            const char* a2 = last ? nA : cA + (size_t)(t + 2) * kstep; const char* b2 = last ? nB : cB + (size_t)(t + 2) * kstep;
            const char* a3 = a2 + kstep; const char* b3 = b2 + kstep;
            if (last && has_next) S.a_ready(nxt);
            if constexpr (SP2) {
            PG8_LDB(B0, 0, 0); PG8_LDB(B1, 0, 1); PG8_SCHED; PG8_LDA(At, 0, 0); PG8_STAGE(PG8_SA(1, 1), a1 + hstep, voffA);
            PG8_WAIT_V(8); PG8_WAIT_L(0); PG8_BAR; PG8_MMA(0, 0, At, B0); PG8_MMA(0, 1, At, B1); PG8_BAR; PG8_SCHED;
            PG8_LDA(At, 0, 1); PG8_STAGE(PG8_SB(0, 0), b2, voffB); PG8_STAGE(PG8_SB(0, 1), b2 + hstep, voffB); PG8_STAGE(PG8_SA(0, 0), a2, voffA);
            PG8_WAIT_V(8); PG8_WAIT_L(0); PG8_BAR; PG8_MMA(1, 0, At, B0); PG8_MMA(1, 1, At, B1); PG8_BAR; PG8_SCHED;
            PG8_LDB(B0, 1, 0); PG8_LDB(B1, 1, 1); PG8_SCHED; PG8_LDA(At, 1, 0); PG8_STAGE(PG8_SA(0, 1), a2 + hstep, voffA);
            PG8_WAIT_V(8); PG8_WAIT_L(0); PG8_BAR; PG8_MMA(0, 0, At, B0); PG8_MMA(0, 1, At, B1); PG8_BAR; PG8_SCHED;
            PG8_LDA(At, 1, 1); PG8_STAGE(PG8_SB(1, 0), b3, voffB); PG8_STAGE(PG8_SB(1, 1), b3 + hstep, voffB); PG8_STAGE(PG8_SA(1, 0), a3, voffA);
            PG8_WAIT_V(8); PG8_WAIT_L(0); PG8_BAR; PG8_MMA(1, 0, At, B0); PG8_MMA(1, 1, At, B1); PG8_BAR; PG8_SCHED;
            } else {
            PG8_LDB(B0, 0, 0); PG8_SCHED; PG8_LDA(At, 0, 0); PG8_STAGE(PG8_SA(1, 1), a1 + hstep, voffA);
            PG8_WAIT_L(8); PG8_BAR; PG8_WAIT_L(0); PG8_MMA(0, 0, At, B0); PG8_BAR; PG8_SCHED;
            PG8_LDB(B1, 0, 1); PG8_STAGE(PG8_SB(0, 0), b2, voffB);
            PG8_BAR; PG8_WAIT_L(0); PG8_MMA(0, 1, At, B1); PG8_BAR;
            PG8_LDA(At, 0, 1); PG8_STAGE(PG8_SA(0, 0), a2, voffA);
            PG8_BAR; PG8_WAIT_L(0); PG8_MMA(1, 0, At, B0); PG8_BAR; PG8_SCHED;
            PG8_STAGE(PG8_SB(0, 1), b2 + hstep, voffB);
            PG8_WAIT_V(6); PG8_BAR; PG8_MMA(1, 1, At, B1); PG8_BAR;
            PG8_LDB(B0, 1, 0); PG8_SCHED; PG8_LDA(At, 1, 0); PG8_STAGE(PG8_SA(0, 1), a2 + hstep, voffA);
            PG8_WAIT_L(8); PG8_BAR; PG8_WAIT_L(0); PG8_MMA(0, 0, At, B0); PG8_BAR; PG8_SCHED;
            PG8_LDB(B1, 1, 1); PG8_STAGE(PG8_SB(1, 0), b3, voffB);
            PG8_BAR; PG8_WAIT_L(0); PG8_MMA(0, 1, At, B1); PG8_BAR;
            PG8_LDA(At, 1, 1); PG8_STAGE(PG8_SA(1, 0), a3, voffA);
            PG8_BAR; PG8_WAIT_L(0); PG8_MMA(1, 0, At, B0); PG8_BAR; PG8_SCHED;
            PG8_STAGE(PG8_SB(1, 1), b3 + hstep, voffB);
            PG8_WAIT_V(6); PG8_BAR; PG8_MMA(1, 1, At, B1); PG8_BAR;
            }
        }
        if constexpr (ALIGN_EPI) { if (wr == 0) PG8_BAR; }
        if constexpr (!Epi::AFTER_DRAIN) { E(acc, cur, wr, wc, fr, fq); S.done(cur); }
        if (!has_next) break;
#pragma unroll
        for (int a = 0; a < 2; ++a)
#pragma unroll
            for (int b = 0; b < 2; ++b)
#pragma unroll
                for (int m = 0; m < 4; ++m)
#pragma unroll
                    for (int n = 0; n < 2; ++n) acc[a][b][m][n] = (f32x4){0.f, 0.f, 0.f, 0.f};
        cur = nxt; cA = nA; cB = nB; ++ui;
        if constexpr (ALIGN_EPI) { if (wr == 1) PG8_BAR; }
    }
    PG8_WAIT_V(0);
    if constexpr (!ALIGN_EPI) { if (wr == 0) PG8_BAR; }
    PG8_BAR;
    if constexpr (Epi::AFTER_DRAIN) { E.fused(acc, cur, wr, wc, fr, fq, lds, wid, lane); S.done(cur); }
#undef PG8_SA
#undef PG8_SB
#undef PG8_STAGE
#undef PG8_LDA
#undef PG8_LDB
#undef PG8_MMA
#undef PG8_WAIT_V
#undef PG8_WAIT_L
#undef PG8_BAR
#undef PG8_SCHED
}
}

#define GAS __attribute__((address_space(1)))
#define LAS __attribute__((address_space(3)))
typedef unsigned short bf16;
typedef float f32x4 __attribute__((ext_vector_type(4)));
typedef float f32x2 __attribute__((ext_vector_type(2)));
typedef float f32x16 __attribute__((ext_vector_type(16)));
typedef short bf16x8 __attribute__((ext_vector_type(8)));
typedef unsigned u32x4 __attribute__((ext_vector_type(4)));
typedef unsigned u32x2 __attribute__((ext_vector_type(2)));
typedef __bf16 bf16x2_t __attribute__((ext_vector_type(2)));

constexpr int NWAVES = 8, NTHR = 512;
constexpr int NB = 8, SEQ = 2048, DM = 1024, MTOK = NB * SEQ;
constexpr int EIN_SRC = 3104, EIN_N = 3328, FF = 2816, FGU_N = 2 * FF, OIN_SRC = 416, OIN_N = 512, UQ_N = 1536, UKV_N = 2048, NEXP = 8;
constexpr int MAXT = 136, HALFT = 68;
constexpr float ALPHA = 1.4142135623730951f;
constexpr float LOG2E = 1.4426950408889634f;
constexpr float LAM_INIT = 0.2f;

constexpr size_t MiB = 1u << 20;
constexpr size_t WS_CTL = 0, CTL_ZERO_BYTES = 1 * MiB;
constexpr size_t WS_W_EIN = 1 * MiB, WS_W_EOUT = 8 * MiB, WS_W_FGU = 10 * MiB, WS_W_FDN = 21 * MiB, WS_W_OIN = 27 * MiB, WS_W_UQ = 28 * MiB, WS_W_UKV = 29 * MiB,
                 WS_W_OOUT = 30 * MiB, WS_W_MGU = 32 * MiB, WS_W_MDN = 120 * MiB;
constexpr size_t WS_TAB = 164 * MiB;
constexpr size_t WS_ROPE = WS_TAB, WS_LUT = WS_TAB + 256 * 1024, WS_TOKE = WS_TAB + 512 * 1024, WS_TOKW = WS_TAB + 640 * 1024, WS_POS = WS_TAB + 768 * 1024,
                 WS_BLKCNT = WS_TAB + 896 * 1024, WS_TILEE = WS_TAB + 960 * 1024;
constexpr size_t WS_XB = 166 * MiB;
constexpr size_t WS_QG = 198 * MiB, WS_KG = 206 * MiB, WS_VG = 214 * MiB, WS_GG = 230 * MiB, WS_QD = 246 * MiB, WS_KD = 262 * MiB, WS_VDT = 278 * MiB, WS_ALR = 294 * MiB,
                 WS_OB = 296 * MiB, WS_AO = 328 * MiB, WS_OF = WS_XB;
constexpr size_t WS_H = 198 * MiB;
constexpr size_t WS_CQ = 198 * MiB, WS_CKV = 214 * MiB, WS_KR = 222 * MiB, WS_CQN = 224 * MiB, WS_CKVN = 232 * MiB, WS_Q = 236 * MiB, WS_K = 284 * MiB, WS_VT = 332 * MiB, WS_AO2 = 198 * MiB;
constexpr size_t WS_XP = 198 * MiB, WS_HP = 266 * MiB;
constexpr size_t WS_END = 364 * MiB;
static_assert(WS_HP + (size_t)HALFT * 256 * FF * 2 <= WS_END && WS_XP + (size_t)MAXT * 256 * DM * 2 <= WS_HP, "moe map");
constexpr int CW_BAR = 4096;
constexpr int RING_BYTES = 131072, LDSCTL_OFF = RING_BYTES, MISC_OFF = LDSCTL_OFF + 320, LDS_BYTES = 147456;

#define RLX_AGENT __ATOMIC_RELAXED, __HIP_MEMORY_SCOPE_AGENT
#define LDS_WAIT() asm volatile("s_waitcnt lgkmcnt(0)" ::: "memory")
__device__ __forceinline__ unsigned f2bf(float f) { unsigned u = __builtin_bit_cast(unsigned, f); return (u + 0x7fffu + ((u >> 16) & 1u)) >> 16; }
__device__ __forceinline__ unsigned pk2(float lo, float hi) { return f2bf(lo) | (f2bf(hi) << 16); }
__device__ __forceinline__ float bf2f(unsigned short b) { return __builtin_bit_cast(float, (unsigned)b << 16); }
__device__ __forceinline__ unsigned cvtpk(float lo, float hi) { f32x2 v = {lo, hi}; bf16x2_t b = __builtin_convertvector(v, bf16x2_t); return __builtin_bit_cast(unsigned, b); }
__device__ __forceinline__ float wave_sum(float v) {
#pragma unroll
    for (int o = 1; o < 64; o <<= 1) v += __shfl_xor(v, o);
    return v;
}

#define XB_TMO      128
#define XB_XCNT(j)  (256  + 64 * (j))
#define XB_XSUB(j)  (1280 + 64 * (j))
#define XB_XGEN(j)  (2304 + 64 * (j))
#define XB_TOP      3328
#define XB_TOPGEN   3392
#define XCD_BAR_WORDS 3456
#define XB_SPIN_CAP (1u << 18)
__device__ __forceinline__ unsigned xb_ld(unsigned* p)              { return __hip_atomic_load(p, __ATOMIC_RELAXED, __HIP_MEMORY_SCOPE_AGENT); }
__device__ __forceinline__ unsigned xb_add(unsigned* p, unsigned v) { return __hip_atomic_fetch_add(p, v, __ATOMIC_RELAXED, __HIP_MEMORY_SCOPE_AGENT); }
__device__ __forceinline__ unsigned xb_xcc_id() { return (unsigned)__builtin_amdgcn_s_getreg((3 << 11) | 20) & 0xFu; }
#define XB_SPIN(cond, bar) do { unsigned _sp = 0; while (cond) { __builtin_amdgcn_s_sleep(1); \
    if ((++_sp & 255u) == 0u) { if (xb_ld(&(bar)[XB_TMO])) break; if (_sp > XB_SPIN_CAP) { atomicAdd(&(bar)[XB_TMO], 1u); break; } } } } while (0)
struct XcdBarrier { unsigned* bar; unsigned x; volatile LAS unsigned* st; };
__device__ __forceinline__ XcdBarrier xcd_barrier_post(unsigned* bar, volatile LAS unsigned* st) {
    XcdBarrier b; b.bar = bar; b.x = xb_xcc_id(); b.st = st;
    if (threadIdx.x == 0) (void)xb_add(&bar[XB_XCNT(b.x)], 1u);
    return b;
}
__device__ __forceinline__ void xcd_barrier_complete(unsigned* bar, unsigned x, unsigned& nloc, unsigned& nx) {
    const unsigned G = gridDim.x * gridDim.y * gridDim.z;
    unsigned sum, cnt, mine, sp = 0u;
    for (;;) {
        sum = 0u; cnt = 0u; mine = 0u;
#pragma unroll
        for (unsigned j = 0; j < 16; ++j) { const unsigned c = xb_ld(&bar[XB_XCNT(j)]); sum += c; cnt += (c > 0u) ? 1u : 0u; mine = (j == x) ? c : mine; }
        if (sum == G) break;
        __builtin_amdgcn_s_sleep(1);
        if ((++sp & 255u) == 0u) { if (xb_ld(&bar[XB_TMO])) break; if (sp > XB_SPIN_CAP) { atomicAdd(&bar[XB_TMO], 1u); break; } }
    }
    nloc = mine > 0u ? mine : 1u; nx = cnt > 0u ? cnt : 1u;
}
__device__ __forceinline__ void xcd_barrier(const XcdBarrier& b) {
    asm volatile("s_waitcnt vmcnt(0)" ::: "memory");
    __syncthreads();
    if (threadIdx.x == 0) {
        unsigned* bar = b.bar;
        __builtin_amdgcn_s_waitcnt(0);
        unsigned nloc = b.st[0], nx = b.st[1];
        if (nloc == 0u) { xcd_barrier_complete(bar, b.x, nloc, nx); b.st[0] = nloc; b.st[1] = nx; }
        const unsigned old = xb_add(&bar[XB_XSUB(b.x)], 1u);
        const unsigned gen = old / nloc;
        if (old + 1u == (gen + 1u) * nloc) {
            __builtin_amdgcn_fence(__ATOMIC_RELEASE, "agent");
            asm volatile("s_waitcnt vmcnt(0)" ::: "memory");
            const unsigned og = xb_add(&bar[XB_TOP], 1u);
            const unsigned tg = og / nx;
            if (og + 1u == (tg + 1u) * nx) xb_add(&bar[XB_TOPGEN], 1u);
            else XB_SPIN(xb_ld(&bar[XB_TOPGEN]) == tg, bar);
            __builtin_amdgcn_fence(__ATOMIC_ACQUIRE, "agent");
            xb_add(&bar[XB_XGEN(b.x)], 1u);
            asm volatile("s_waitcnt vmcnt(0)" ::: "memory");
        } else {
            XB_SPIN(xb_ld(&bar[XB_XGEN(b.x)]) == gen, bar);
            __builtin_amdgcn_fence(__ATOMIC_ACQUIRE, "agent");
            asm volatile("s_waitcnt vmcnt(0)" ::: "memory");
        }
    }
    __syncthreads();
}

__device__ __forceinline__ void tr_item(const float* W, int K, int N, bf16* WT, int dstrow0, LAS float* scr, int kb, int n0, int lane) {
    const int k0 = 64 * kb;
#pragma unroll 8
    for (int i = 0; i < 32; ++i) { const int kk = 2 * i + (lane >> 5); scr[kk * 33 + (lane & 31)] = W[(size_t)(k0 + kk) * N + n0 + (lane & 31)]; }
    LDS_WAIT(); asm volatile("" ::: "memory");
    const int c = lane & 7;
#pragma unroll
    for (int j = 0; j < 4; ++j) { const int n = (lane >> 3) + 8 * j; const LAS float* s = scr + (8 * c) * 33 + n;
        u32x4 o; o.x = pk2(s[0 * 33], s[1 * 33]); o.y = pk2(s[2 * 33], s[3 * 33]); o.z = pk2(s[4 * 33], s[5 * 33]); o.w = pk2(s[6 * 33], s[7 * 33]);
        *(GAS u32x4*)(WT + (size_t)(dstrow0 + n) * K + k0 + 8 * c) = o; }
    LDS_WAIT(); asm volatile("" ::: "memory");
}
template <int MODE>
__device__ __forceinline__ void tr_matrix(const float* W, int K, int N, bf16* WT, int row_off, LAS float* scr, int gw, int NGW, int lane) {
    const int nblk = N / 32, nitems = (K / 64) * nblk;
    for (int it = gw; it < nitems; it += NGW) { const int kb = it / nblk, n0 = 32 * (it % nblk); int d;
        if (MODE == 0) d = n0;
        else if (MODE == 1) d = (n0 < 1536) ? n0 : (n0 == 1536 ? 3072 : n0 - 32);
        else d = 256 * (n0 >> 7) + (n0 & 127) + (MODE == 3 ? 128 : 0);
        tr_item(W, K, N, WT, row_off + d, scr, kb, n0, lane); }
}
__device__ __forceinline__ void row_to_bf16(const float* xrow, bf16* orow, int lane) {
    const GAS f32x4* xr = (const GAS f32x4*)xrow + lane; GAS unsigned long long* o8 = (GAS unsigned long long*)orow + lane;
#pragma unroll
    for (int j = 0; j < 4; ++j) { const f32x4 v = xr[64 * j]; o8[64 * j] = (unsigned long long)pk2(v.x, v.y) | ((unsigned long long)pk2(v.z, v.w) << 32); }
}
__device__ __forceinline__ void ln_apply(f32x4 (&v)[4], const float* g, const float* b, int lane) {
    float s = 0.f;
#pragma unroll
    for (int j = 0; j < 4; ++j) s += (v[j].x + v[j].y) + (v[j].z + v[j].w);
    const float mean = wave_sum(s) * (1.f / DM); float s2 = 0.f;
#pragma unroll
    for (int j = 0; j < 4; ++j) { v[j] = v[j] - mean; s2 += (v[j].x * v[j].x + v[j].y * v[j].y) + (v[j].z * v[j].z + v[j].w * v[j].w); }
    const float rstd = 1.f / sqrtf(wave_sum(s2) * (1.f / DM) + 1e-5f);
#pragma unroll
    for (int j = 0; j < 4; ++j) { const f32x4 gg = *((const f32x4*)g + lane + 64 * j), bb = *((const f32x4*)b + lane + 64 * j); v[j] = v[j] * rstd * gg + bb; }
}
__device__ __forceinline__ void store_row_f32_bf16(const f32x4 (&v)[4], float* frow, bf16* brow, int lane) {
    GAS f32x4* fr = (GAS f32x4*)frow + lane; GAS unsigned long long* o8 = (GAS unsigned long long*)brow + lane;
#pragma unroll
    for (int j = 0; j < 4; ++j) { fr[64 * j] = v[j]; o8[64 * j] = (unsigned long long)pk2(v[j].x, v[j].y) | ((unsigned long long)pk2(v[j].z, v[j].w) << 32); }
}

struct AttnP {
    const bf16* Q; const bf16* K; const bf16* VT; bf16* O;
    const float* lut;
    const float* dlam;
    const float* dgain;
};
template <bool DIFF>
__device__ __forceinline__ void attn_phase(LAS unsigned char* lds, const AttnP& P, int G, int c, unsigned* qctr) {
    constexpr int KW = DIFF ? 128 : 96, DQ = DIFF ? 64 : 96, DV = DIFF ? 128 : 64, NH = DIFF ? 4 : 16;
    constexpr int LDQ = DIFF ? 512 : 1536, LDK = DIFF ? 512 : 1536, HQ = DIFF ? 128 : 96;
    constexpr int KPITCH = KW * 2 + 16, VPITCH = 144, KBYTES = 64 * KPITCH, VBYTES = DV * VPITCH, STAGE = KBYTES + VBYTES;
    constexpr int NDS = DQ / 16, NRB = DV / 32, KPR = KW / 8, NKPIECE = 64 * KPR, NVPIECE = DV * 8;
    constexpr int NKI = (NKPIECE + NTHR - 1) / NTHR, NVI = (NVPIECE + NTHR - 1) / NTHR;
    constexpr int QROWS = DIFF ? 128 : 256, NQB = SEQ / QROWS, NUNITS = NB * NH * NQB;
    constexpr int LUT_OFF = 2 * STAGE;
    static_assert(LUT_OFF + (DIFF ? 8192 : 0) <= RING_BYTES && 2 * STAGE >= (DIFF ? 65536 : 0), "attn lds");
    const int tid = threadIdx.x, lane = tid & 63, wid = __builtin_amdgcn_readfirstlane(tid >> 6), r = lane & 31, h2 = lane >> 5;
    const int pir = (r & ~12) | ((r & 4) << 1) | ((r & 8) >> 1);
    float lam = 0.f;
    if (DIFF) {
        LAS float* L = (LAS float*)(lds + LUT_OFF);
        for (int i = tid; i < 4 * 512; i += NTHR) L[i] = P.lut[i];
        const float a = P.dlam[lane] * P.dlam[64 + lane], b2 = P.dlam[128 + lane] * P.dlam[192 + lane];
        lam = __expf(wave_sum(a)) - __expf(wave_sum(b2)) + LAM_INIT;
        __syncthreads();
    }
    for (int it = 0;; ++it) {
        int unit;
        if (qctr) {
            __syncthreads();
            if (tid == 0) *(volatile LAS int*)(lds + RING_BYTES - 16) = (int)__hip_atomic_fetch_add(qctr, 1u, __ATOMIC_RELAXED, __HIP_MEMORY_SCOPE_AGENT);
            __syncthreads();
            unit = *(volatile LAS int*)(lds + RING_BYTES - 16);
        } else unit = c + it * G;
        if (unit >= NUNITS) break;
        int b, h, q0, map;
        if (DIFF) { const int qb = unit & 15; h = (unit >> 4) & 3; b = unit >> 6; map = wid >> 2; q0 = qb * 128 + 32 * (wid & 3); }
        else { const int qb = unit & 7; h = (unit >> 3) & 15; b = unit >> 7; map = 0; q0 = qb * 256 + 32 * wid; }
        const size_t tok0 = (size_t)b * SEQ;
        bf16x8 qf[NDS];
        { const bf16* qp = P.Q + (tok0 + q0 + r) * LDQ + h * HQ + map * 64 + 8 * h2;
#pragma unroll
          for (int ds = 0; ds < NDS; ++ds) qf[ds] = *(const bf16x8*)(qp + 16 * ds); }
        const bf16* Kb = P.K + tok0 * LDK + h * HQ;
        const bf16* Vb = P.VT + (size_t)(b * NH + h) * DV * SEQ;
        u32x4 kst[NKI], vst[NVI];
#define ATT_LOAD(t) do { \
        _Pragma("unroll") for (int i = 0; i < NKI; ++i) { const int p = tid + i * NTHR; if (NKPIECE % NTHR == 0 || p < NKPIECE) { const int row = p / KPR, cp = p % KPR; kst[i] = *(const u32x4*)(Kb + (size_t)(64 * (t) + row) * LDK + 8 * cp); } } \
        _Pragma("unroll") for (int i = 0; i < NVI; ++i) { const int p = tid + i * NTHR; const int row = p >> 3, cp = p & 7; vst[i] = *(const u32x4*)(Vb + (size_t)row * SEQ + 64 * (t) + 8 * cp); } } while (0)
#define ATT_STORE(buf) do { \
        _Pragma("unroll") for (int i = 0; i < NKI; ++i) { const int p = tid + i * NTHR; if (NKPIECE % NTHR == 0 || p < NKPIECE) { const int row = p / KPR, cp = p % KPR; *(LAS u32x4*)(lds + (buf) * STAGE + row * KPITCH + 16 * cp) = kst[i]; } } \
        _Pragma("unroll") for (int i = 0; i < NVI; ++i) { const int p = tid + i * NTHR; const int row = p >> 3, cp = p & 7; *(LAS u32x4*)(lds + (buf) * STAGE + KBYTES + row * VPITCH + 16 * cp) = vst[i]; } } while (0)
        f32x16 O[NRB];
#pragma unroll
        for (int rb = 0; rb < NRB; ++rb)
#pragma unroll
            for (int i = 0; i < 16; ++i) O[rb][i] = 0.f;
        float mrun = -1e30f, lrun = 0.f;
        ATT_LOAD(0); ATT_STORE(0); __syncthreads();
        const int koff = pir * KPITCH + (map * 64 + 8 * h2) * 2, voff = KBYTES + r * VPITCH + 16 * h2;
        const int qpos = q0 + r, qlo = q0, qhi = q0 + 31;
        for (int t = 0; t < SEQ / 64; ++t) {
            const int buf = t & 1;
            if (t + 1 < SEQ / 64) ATT_LOAD(t + 1);
            const LAS unsigned char* kb = lds + buf * STAGE + koff; const LAS unsigned char* vb = lds + buf * STAGE + voff;
            f32x16 st[2];
#pragma unroll
            for (int kg = 0; kg < 2; ++kg) {
#pragma unroll
                for (int i = 0; i < 16; ++i) st[kg][i] = 0.f;
#pragma unroll
                for (int ds = 0; ds < NDS; ++ds) { const bf16x8 kf = *(const LAS bf16x8*)(kb + kg * 32 * KPITCH + ds * 32); st[kg] = __builtin_amdgcn_mfma_f32_32x32x16_bf16(kf, qf[ds], st[kg], 0, 0, 0); }
            }
            if (DIFF) {
                const LAS float* L = (const LAS float*)(lds + LUT_OFF) + h * 512;
                const int k0 = 64 * t;
                if (k0 - qhi >= 91) { const float cb = L[256 + 100];
#pragma unroll
                    for (int kg = 0; kg < 2; ++kg)
#pragma unroll
                        for (int i = 0; i < 16; ++i) st[kg][i] += cb;
                } else if (qlo - (k0 + 63) >= 91) { const float cb = L[256 - 100];
#pragma unroll
                    for (int kg = 0; kg < 2; ++kg)
#pragma unroll
                        for (int i = 0; i < 16; ++i) st[kg][i] += cb;
                } else {
                    const int base = k0 + 8 * h2 - qpos + 256;
#pragma unroll
                    for (int kg = 0; kg < 2; ++kg)
#pragma unroll
                        for (int i = 0; i < 16; ++i) st[kg][i] += L[base + 32 * kg + 16 * (i >> 3) + (i & 7)];
                }
            }
            float mx = st[0][0];
#pragma unroll
            for (int i = 1; i < 16; ++i) mx = fmaxf(mx, st[0][i]);
#pragma unroll
            for (int i = 0; i < 16; ++i) mx = fmaxf(mx, st[1][i]);
            mx = fmaxf(mx, __shfl_xor(mx, 32));
            const float mnew = fmaxf(mrun, mx); const float alpha = __builtin_amdgcn_exp2f(mrun - mnew); mrun = mnew;
            float rs = 0.f;
#pragma unroll
            for (int kg = 0; kg < 2; ++kg)
#pragma unroll
                for (int i = 0; i < 16; ++i) { const float p = __builtin_amdgcn_exp2f(st[kg][i] - mnew); st[kg][i] = p; rs += p; }
            lrun = lrun * alpha + rs;
#pragma unroll
            for (int rb = 0; rb < NRB; ++rb)
#pragma unroll
                for (int i = 0; i < 16; ++i) O[rb][i] *= alpha;
            bf16x8 pf[2][2];
#pragma unroll
            for (int kg = 0; kg < 2; ++kg)
#pragma unroll
                for (int s2 = 0; s2 < 2; ++s2) { u32x4 w; w.x = cvtpk(st[kg][8 * s2 + 0], st[kg][8 * s2 + 1]); w.y = cvtpk(st[kg][8 * s2 + 2], st[kg][8 * s2 + 3]);
                    w.z = cvtpk(st[kg][8 * s2 + 4], st[kg][8 * s2 + 5]); w.w = cvtpk(st[kg][8 * s2 + 6], st[kg][8 * s2 + 7]); pf[kg][s2] = __builtin_bit_cast(bf16x8, w); }
#pragma unroll
            for (int rb = 0; rb < NRB; ++rb) {
#pragma unroll
                for (int kg = 0; kg < 2; ++kg)
#pragma unroll
                    for (int s2 = 0; s2 < 2; ++s2) { const bf16x8 vf = *(const LAS bf16x8*)(vb + rb * 32 * VPITCH + (32 * kg + 16 * s2) * 2); O[rb] = __builtin_amdgcn_mfma_f32_32x32x16_bf16(vf, pf[kg][s2], O[rb], 0, 0, 0); }
                __builtin_amdgcn_sched_barrier(0); }
            if (t + 1 < SEQ / 64) ATT_STORE(buf ^ 1);
            __syncthreads();
        }
        const float ltot = lrun + __shfl_xor(lrun, 32); const float inv = 1.0f / ltot;
        int lane_e = lane; asm volatile("" : "+v"(lane_e));
        const int r_e = lane_e & 31, h2_e = lane_e >> 5;
        if (!DIFF) {
            bf16* op = P.O + (tok0 + q0 + r_e) * DM + h * 64 + 4 * h2_e;
#pragma unroll
            for (int rb = 0; rb < NRB; ++rb)
#pragma unroll
                for (int g = 0; g < 4; ++g) { u32x2 w; w.x = cvtpk(O[rb][4 * g] * inv, O[rb][4 * g + 1] * inv); w.y = cvtpk(O[rb][4 * g + 2] * inv, O[rb][4 * g + 3] * inv); *(u32x2*)(op + 32 * rb + 8 * g) = w; }
        } else {
            LAS float* X = (LAS float*)lds;
            if (map == 1) { const float sc = inv * lam;
#pragma unroll
                for (int rb = 0; rb < NRB; ++rb)
#pragma unroll
                    for (int i = 0; i < 16; ++i) X[((wid - 4) * 64 + rb * 16 + i) * 64 + lane_e] = O[rb][i] * sc; }
            __syncthreads();
            if (map == 0) { float ss = 0.f;
#pragma unroll
                for (int rb = 0; rb < NRB; ++rb)
#pragma unroll
                    for (int i = 0; i < 16; ++i) { const float o = O[rb][i] * inv - X[(wid * 64 + rb * 16 + i) * 64 + lane_e]; O[rb][i] = o; ss += o * o; }
                ss += __shfl_xor(ss, 32);
                const float rn = (1.0f - LAM_INIT) / sqrtf(ss * (1.0f / 128.0f) + 1e-6f);
                bf16* op = P.O + (tok0 + q0 + r_e) * DM + 512 + h * 128 + 4 * h2_e;
#pragma unroll
                for (int rb = 0; rb < NRB; ++rb)
#pragma unroll
                    for (int g = 0; g < 4; ++g) { const f32x4 gn = *(const f32x4*)(P.dgain + 32 * rb + 8 * g + 4 * h2_e);
                        u32x2 w; w.x = cvtpk(O[rb][4 * g] * rn * gn[0], O[rb][4 * g + 1] * rn * gn[1]); w.y = cvtpk(O[rb][4 * g + 2] * rn * gn[2], O[rb][4 * g + 3] * rn * gn[3]); *(u32x2*)(op + 32 * rb + 8 * g) = w; }
            }
            __syncthreads();
        }
#undef ATT_LOAD
#undef ATT_STORE
    }
}

struct GlaP { const bf16 *QG, *KG, *VGT; const float* ALR; const float* gate_up; const float* gate_bias; float* OF; float* OB; };
__device__ __forceinline__ void gla_unit(LAS unsigned char* lds, const GlaP& P, int unit) {
    constexpr int PITCH = 144, QD_OFF = 0, KN_OFF = 64 * PITCH, KE_OFF = 2 * 64 * PITCH, VT_OFF = 3 * 64 * PITCH, DC_OFF = VT_OFF + 128 * PITCH, BUF = DC_OFF + 256;
    constexpr int SG_OFF = 2 * BUF, AL_OFF = SG_OFF + 2 * 8 * 64 * 4, GLA_END = AL_OFF + 2 * 64 * 16 * 4;
    static_assert(GLA_END <= RING_BYTES, "gla lds");
    const int tid = threadIdx.x, lane = tid & 63, wid = __builtin_amdgcn_readfirstlane(tid >> 6), r = lane & 31, h2 = lane >> 5;
    const int tb = wid >> 2, db = wid & 3;
    const int b = unit >> 3, h = (unit >> 1) & 3, dir = unit & 1;
    const int pl = (lane & ~12) | ((lane & 4) << 1) | ((lane & 8) >> 1), pir = (r & ~12) | ((r & 4) << 1) | ((r & 8) >> 1);
    const size_t tok0 = (size_t)b * SEQ;
    float GU[16];
#pragma unroll
    for (int rr = 0; rr < 16; ++rr) GU[rr] = P.gate_up[(size_t)(dir * 16 + rr) * 256 + h * 64 + lane];
    const float gb = P.gate_bias[dir * 256 + h * 64 + lane];
    float* OUT = dir ? P.OB : P.OF;
    f32x16 S0, S1;
#pragma unroll
    for (int i = 0; i < 16; ++i) { S0[i] = 0.f; S1[i] = 0.f; }
    unsigned short qraw[8], kraw[8]; u32x4 vraw[2]; f32x2 alr;
#define GLA_TBASE(c) (tok0 + (size_t)64 * (dir ? (SEQ / 64 - 1 - (c)) : (c)))
#define GLA_LOAD_QKV(c) do { const size_t tbs_ = GLA_TBASE(c); \
        _Pragma("unroll") for (int tt = 0; tt < 8; ++tt) { const size_t o_ = (tbs_ + 8 * wid + tt) * 256 + h * 64 + lane; qraw[tt] = P.QG[o_]; kraw[tt] = P.KG[o_]; } \
        _Pragma("unroll") for (int i = 0; i < 2; ++i) { const int p_ = tid + i * NTHR; vraw[i] = *(const u32x4*)(P.VGT + ((size_t)(b * 4 + h) * 128 + (p_ >> 3)) * SEQ + (tbs_ - tok0) + 8 * (p_ & 7)); } } while (0)
#define GLA_LOAD_AL(c) do { alr = *(const f32x2*)(P.ALR + (GLA_TBASE(c) + (tid >> 3)) * 32 + dir * 16 + 2 * (tid & 7)); } while (0)
    __syncthreads();
    GLA_LOAD_AL(0); GLA_LOAD_QKV(0);
    *(LAS f32x2*)(lds + AL_OFF + tid * 8) = alr;
    __syncthreads();
    for (int c = 0; c < SEQ / 64; ++c) {
        const int buf = c & 1; LAS unsigned char* B = lds + buf * BUF;
        if (c + 1 < SEQ / 64) GLA_LOAD_AL(c + 1);
        float p[8]; float segtot;
        { const LAS f32x4* al4 = (const LAS f32x4*)(lds + AL_OFF + buf * 4096) + (8 * wid) * 4; float la[8];
#pragma unroll
          for (int tt = 0; tt < 8; ++tt) { float x = gb;
#pragma unroll
              for (int q4 = 0; q4 < 4; ++q4) { const f32x4 a = al4[tt * 4 + q4]; x += a[0] * GU[4 * q4] + a[1] * GU[4 * q4 + 1] + a[2] * GU[4 * q4 + 2] + a[3] * GU[4 * q4 + 3]; }
              la[tt] = (fminf(x, 0.f) - log1pf(__expf(-fabsf(x)))) * (1.0f / 16.0f); }
          if (!dir) { float a = 0.f;
#pragma unroll
              for (int tt = 0; tt < 8; ++tt) { a += la[tt]; p[tt] = a; } segtot = a; }
          else { float a = 0.f;
#pragma unroll
              for (int tt = 7; tt >= 0; --tt) { a += la[tt]; p[tt] = a; } segtot = a; } }
        ((LAS float*)(lds + SG_OFF + buf * 2048))[wid * 64 + lane] = segtot;
        __syncthreads();
        { const LAS float* sg = (const LAS float*)(lds + SG_OFF + buf * 2048) + lane; float tot = 0.f, off = 0.f;
#pragma unroll
          for (int w = 0; w < 8; ++w) { const float v = sg[w * 64]; tot += v; if (dir ? (w > wid) : (w < wid)) off += v; }
          float ke[8];
#pragma unroll
          for (int tt = 0; tt < 8; ++tt) { const float bt = off + p[tt]; const float e1 = __expf(bt), e2 = __expf(-bt), e3 = __expf(tot - bt);
              const float qv = bf2f(qraw[tt]), kv = bf2f(kraw[tt]); const int t = 8 * wid + tt;
              *(LAS unsigned short*)(B + QD_OFF + t * PITCH + 2 * pl) = (unsigned short)f2bf(qv * e1);
              *(LAS unsigned short*)(B + KN_OFF + t * PITCH + 2 * pl) = (unsigned short)f2bf(kv * e2);
              ke[tt] = kv * e3; }
          u32x4 w; w.x = pk2(ke[0], ke[1]); w.y = pk2(ke[2], ke[3]); w.z = pk2(ke[4], ke[5]); w.w = pk2(ke[6], ke[7]);
          *(LAS u32x4*)(B + KE_OFF + lane * PITCH + 16 * wid) = w;
          if (wid == 0) ((LAS float*)(B + DC_OFF))[lane] = __expf(tot);
#pragma unroll
          for (int i = 0; i < 2; ++i) { const int p_ = tid + i * NTHR; *(LAS u32x4*)(B + VT_OFF + (p_ >> 3) * PITCH + 16 * (p_ & 7)) = vraw[i]; }
          if (c + 1 < SEQ / 64) { *(LAS f32x2*)(lds + AL_OFF + (buf ^ 1) * 4096 + tid * 8) = alr; GLA_LOAD_QKV(c + 1); } }
        __syncthreads();
        f32x16 O;
#pragma unroll
        for (int i = 0; i < 16; ++i) O[i] = 0.f;
        const LAS unsigned char* qd_row = B + QD_OFF + (32 * tb + r) * PITCH + 16 * h2;
        const LAS unsigned char* vt_row = B + VT_OFF + (32 * db + r) * PITCH + 16 * h2;
#pragma unroll
        for (int jt = 0; jt < 2; ++jt) {
            const bool full = dir ? (jt > tb) : (jt < tb), diag = (jt == tb);
            if (full || diag) {
                f32x16 st;
#pragma unroll
                for (int i = 0; i < 16; ++i) st[i] = 0.f;
#pragma unroll
                for (int ks = 0; ks < 4; ++ks) { const bf16x8 kf = *(const LAS bf16x8*)(B + KN_OFF + (32 * jt + pir) * PITCH + 16 * h2 + 32 * ks); const bf16x8 qf = *(const LAS bf16x8*)(qd_row + 32 * ks);
                    st = __builtin_amdgcn_mfma_f32_32x32x16_bf16(kf, qf, st, 0, 0, 0); }
                if (diag) {
#pragma unroll
                    for (int i = 0; i < 16; ++i) { const int jl = 16 * (i >> 3) + 8 * h2 + (i & 7); const bool keep = dir ? (jl >= r) : (jl <= r); st[i] = keep ? st[i] : 0.f; } }
#pragma unroll
                for (int s2 = 0; s2 < 2; ++s2) { u32x4 w; w.x = cvtpk(st[8 * s2 + 0], st[8 * s2 + 1]); w.y = cvtpk(st[8 * s2 + 2], st[8 * s2 + 3]); w.z = cvtpk(st[8 * s2 + 4], st[8 * s2 + 5]); w.w = cvtpk(st[8 * s2 + 6], st[8 * s2 + 7]);
                    const bf16x8 vf = *(const LAS bf16x8*)(vt_row + (32 * jt + 16 * s2) * 2);
                    O = __builtin_amdgcn_mfma_f32_32x32x16_bf16(vf, __builtin_bit_cast(bf16x8, w), O, 0, 0, 0); }
            }
        }
#pragma unroll
        for (int s = 0; s < 2; ++s) { u32x4 w0, w1;
            w0.x = cvtpk(S0[8 * s + 0], S0[8 * s + 1]); w0.y = cvtpk(S0[8 * s + 2], S0[8 * s + 3]); w0.z = cvtpk(S0[8 * s + 4], S0[8 * s + 5]); w0.w = cvtpk(S0[8 * s + 6], S0[8 * s + 7]);
            w1.x = cvtpk(S1[8 * s + 0], S1[8 * s + 1]); w1.y = cvtpk(S1[8 * s + 2], S1[8 * s + 3]); w1.z = cvtpk(S1[8 * s + 4], S1[8 * s + 5]); w1.w = cvtpk(S1[8 * s + 6], S1[8 * s + 7]);
            const bf16x8 q0 = *(const LAS bf16x8*)(qd_row + (16 * s) * 2), q1 = *(const LAS bf16x8*)(qd_row + (32 + 16 * s) * 2);
            O = __builtin_amdgcn_mfma_f32_32x32x16_bf16(__builtin_bit_cast(bf16x8, w0), q0, O, 0, 0, 0);
            O = __builtin_amdgcn_mfma_f32_32x32x16_bf16(__builtin_bit_cast(bf16x8, w1), q1, O, 0, 0, 0); }
        { const LAS f32x4* dc = (const LAS f32x4*)(B + DC_OFF) + h2;
#pragma unroll
          for (int g = 0; g < 4; ++g) { const f32x4 d0 = dc[2 * g], d1 = dc[8 + 2 * g];
#pragma unroll
              for (int e = 0; e < 4; ++e) { S0[4 * g + e] *= d0[e]; S1[4 * g + e] *= d1[e]; } }
#pragma unroll
          for (int ks = 0; ks < 4; ++ks) { const bf16x8 vf = *(const LAS bf16x8*)(vt_row + 32 * ks);
              const bf16x8 k0 = *(const LAS bf16x8*)(B + KE_OFF + r * PITCH + 16 * h2 + 32 * ks), k1 = *(const LAS bf16x8*)(B + KE_OFF + (32 + r) * PITCH + 16 * h2 + 32 * ks);
              S0 = __builtin_amdgcn_mfma_f32_32x32x16_bf16(k0, vf, S0, 0, 0, 0); S1 = __builtin_amdgcn_mfma_f32_32x32x16_bf16(k1, vf, S1, 0, 0, 0); } }
        { float* op = OUT + (GLA_TBASE(c) + 32 * tb + r) * 512 + h * 128 + 32 * db + 4 * h2;
#pragma unroll
          for (int g = 0; g < 4; ++g) *(f32x4*)(op + 8 * g) = (f32x4){O[4 * g], O[4 * g + 1], O[4 * g + 2], O[4 * g + 3]}; }
    }
    __syncthreads();
#undef GLA_TBASE
#undef GLA_LOAD_QKV
#undef GLA_LOAD_AL
}

#ifndef MK_PER_PHASE
#define MK_PER_PHASE 0
#endif
constexpr int NPHASE = 21;
struct Args { const float* in[24]; float* out; unsigned char* ws; int ph_lo, ph_hi, flags, pad; };
static_assert(sizeof(Args) == 24 * 8 + 8 + 8 + 16, "Args has no padding");
enum { I_X = 0, I_RELB, I_EWIN, I_GUP, I_GBIAS, I_GLAGAIN, I_DLAM, I_DGAIN, I_EWOUT, I_FG, I_FU, I_FD, I_OWIN, I_QGAIN, I_KVGAIN, I_WUQ, I_WUKV, I_OWOUT, I_ROUTER, I_MG, I_MU, I_MD, I_LNG, I_LNB };

__global__ void __launch_bounds__(NTHR, 2) mega_fwd(Args args) {
    extern __shared__ __attribute__((aligned(16))) unsigned char lds_raw[];
    LAS unsigned char* lds = (LAS unsigned char*)lds_raw;
    volatile LAS unsigned* MISC = (volatile LAS unsigned*)(lds + MISC_OFF);
    const int tid = threadIdx.x, lane = tid & 63, wave = __builtin_amdgcn_readfirstlane(tid >> 6);
    const int G = gridDim.x, bx = blockIdx.x;
    const int vcu = (G % 8 == 0) ? (bx % 8) * (G / 8) + bx / 8 : bx;
    const int gw = vcu * NWAVES + wave, NGW = G * NWAVES;
    unsigned char* ws = args.ws;
    for (int u = tid; u < (LDS_BYTES - LDSCTL_OFF) / 4; u += NTHR) ((LAS unsigned*)(lds + LDSCTL_OFF))[u] = 0u;
    __syncthreads();
    const int lo = args.ph_lo, hi = args.ph_hi;
    XcdBarrier bar; bar.bar = (unsigned*)(ws + WS_CTL) + CW_BAR; bar.x = 0; bar.st = nullptr;
    if (hi - lo > 1) bar = xcd_barrier_post((unsigned*)(ws + WS_CTL) + CW_BAR, MISC + 8);
#ifdef ONLY_PHASE
#define IN(k) ((k) == ONLY_PHASE && lo <= (k) && (k) < hi)
#else
#define IN(k) (lo <= (k) && (k) < hi)
#endif
#define SEAM(k) do { if (IN(k) && IN((k) + 1)) xcd_barrier(bar); } while (0)

    const float* x_in = args.in[I_X];
    const float* ln_g = args.in[I_LNG]; const float* ln_b = args.in[I_LNB];
    float* XF = args.out;
    bf16* W_EIN = (bf16*)(ws + WS_W_EIN); bf16* W_EOUT = (bf16*)(ws + WS_W_EOUT); bf16* W_FGU = (bf16*)(ws + WS_W_FGU); bf16* W_FDN = (bf16*)(ws + WS_W_FDN);
    bf16* W_OIN = (bf16*)(ws + WS_W_OIN); bf16* W_UQ = (bf16*)(ws + WS_W_UQ); bf16* W_UKV = (bf16*)(ws + WS_W_UKV); bf16* W_OOUT = (bf16*)(ws + WS_W_OOUT);
    bf16* W_MGU = (bf16*)(ws + WS_W_MGU); bf16* W_MDN = (bf16*)(ws + WS_W_MDN);
    float* ROPE = (float*)(ws + WS_ROPE); float* LUT = (float*)(ws + WS_LUT);
    int* TOKE = (int*)(ws + WS_TOKE); float* TOKW = (float*)(ws + WS_TOKW); int* POS = (int*)(ws + WS_POS); int* BLKCNT = (int*)(ws + WS_BLKCNT); int* TILEE = (int*)(ws + WS_TILEE);
    bf16* XB = (bf16*)(ws + WS_XB);
    bf16* QG = (bf16*)(ws + WS_QG); bf16* KG = (bf16*)(ws + WS_KG); bf16* VG = (bf16*)(ws + WS_VG); bf16* GG = (bf16*)(ws + WS_GG);
    bf16* QD = (bf16*)(ws + WS_QD); bf16* KD = (bf16*)(ws + WS_KD); bf16* VDT = (bf16*)(ws + WS_VDT); float* ALR = (float*)(ws + WS_ALR);
    float* OFb = (float*)(ws + WS_OF); float* OBb = (float*)(ws + WS_OB); bf16* AO = (bf16*)(ws + WS_AO);
    bf16* Hb = (bf16*)(ws + WS_H);
    float* CQ = (float*)(ws + WS_CQ); float* CKV = (float*)(ws + WS_CKV); float* KR = (float*)(ws + WS_KR); bf16* CQN = (bf16*)(ws + WS_CQN); bf16* CKVN = (bf16*)(ws + WS_CKVN);
    bf16* Qb = (bf16*)(ws + WS_Q); bf16* Kb = (bf16*)(ws + WS_K); bf16* VTb = (bf16*)(ws + WS_VT); bf16* AO2 = (bf16*)(ws + WS_AO2);
    bf16* XP = (bf16*)(ws + WS_XP); bf16* HP = (bf16*)(ws + WS_HP);

    if (IN(0)) {
        LAS float* scr = (LAS float*)(lds + wave * 16384);
        int off = 0;
#define TRM(MODE, W, K, N, WT, ROFF) do { const int nit_ = ((K) / 64) * ((N) / 32); int g0_ = (gw - off) % NGW; if (g0_ < 0) g0_ += NGW; tr_matrix<MODE>((W), (K), (N), (WT), (ROFF), scr, g0_, NGW, lane); off = (off + nit_) % NGW; } while (0)
        TRM(1, args.in[I_EWIN], 1024, EIN_SRC, W_EIN, 0);
        TRM(0, args.in[I_EWOUT], 1024, 1024, W_EOUT, 0);
        TRM(2, args.in[I_FG], 1024, FF, W_FGU, 0);
        TRM(3, args.in[I_FU], 1024, FF, W_FGU, 0);
        TRM(0, args.in[I_FD], FF, 1024, W_FDN, 0);
        TRM(0, args.in[I_OWIN], 1024, OIN_SRC, W_OIN, 0);
        TRM(0, args.in[I_WUQ], 256, UQ_N, W_UQ, 0);
        TRM(0, args.in[I_WUKV], 128, UKV_N, W_UKV, 0);
        TRM(0, args.in[I_OWOUT], 1024, 1024, W_OOUT, 0);
        for (int e = 0; e < NEXP; ++e) {
            TRM(2, args.in[I_MG] + (size_t)e * 1024 * FF, 1024, FF, W_MGU, e * FGU_N);
            TRM(3, args.in[I_MU] + (size_t)e * 1024 * FF, 1024, FF, W_MGU, e * FGU_N);
            TRM(0, args.in[I_MD] + (size_t)e * FF * 1024, FF, 1024, W_MDN, e * 1024);
        }
#undef TRM
        for (int m = gw; m < MTOK; m += NGW) row_to_bf16(x_in + (size_t)m * DM, XB + (size_t)m * DM, lane);
        const int gt = bx * NTHR + tid, NGT = G * NTHR;
        for (int i = gt; i < SEQ * 16; i += NGT) { const int pos = i >> 4, k = i & 15; const float inv = (float)pow(10000.0, -(double)k / 16.0); const float ang = (float)pos * inv;
            ROPE[2 * i] = (float)cos((double)ang); ROPE[2 * i + 1] = (float)sin((double)ang); }
        for (int i = gt; i < 4 * 512; i += NGT) { const int h = i >> 9, rel = (i & 511) - 256; const int n = rel < 0 ? -rel : rel; int bk = rel > 0 ? 16 : 0;
            int nl = n; if (n >= 8) { nl = 8 + (31 - __clz(n * n)) - 6; if (nl > 15) nl = 15; }
            bk += nl; LUT[i] = args.in[I_RELB][bk * 4 + h] * LOG2E; }
    }
    SEAM(0);
    if (IN(1)) {
        pg8::Gemm g{XB, W_EIN, MTOK, EIN_N, DM}; pg8::StaticOrder S; S.init(MTOK, EIN_N, G, bx);
        pg8::EpiEvenIn E{QG, KG, VG, GG, QD, KD, VDT, ALR};
        pg8::gemm_phase<pg8::EpiEvenIn, pg8::StaticOrder, true, true>(lds, g, S, E);
    }
    SEAM(1);
    if (IN(2)) {
        const GlaP GP{QG, KG, VG, ALR, args.in[I_GUP], args.in[I_GBIAS], OFb, OBb};
        if (!(args.flags & 1)) for (int u = bx; u < 64; u += G) gla_unit(lds, GP, u);
        __syncthreads();
        const AttnP AP{QD, KD, VDT, AO, LUT, args.in[I_DLAM], args.in[I_DGAIN]};
        if (!(args.flags & 2)) attn_phase<true>(lds, AP, G, bx, (hi - lo > 1) ? (unsigned*)(ws + WS_CTL) + 64 : nullptr);
    }
    SEAM(2);
    if (IN(3)) {
        const float* ggain = args.in[I_GLAGAIN];
        for (int m = gw; m < MTOK; m += NGW) {
            const int hh = lane >> 4, c8 = (lane & 15) * 8; const size_t o = (size_t)m * 512 + hh * 128 + c8;
            const f32x4 a0 = *(const f32x4*)(OFb + o), a1 = *(const f32x4*)(OFb + o + 4), b0 = *(const f32x4*)(OBb + o), b1 = *(const f32x4*)(OBb + o + 4);
            const f32x4 v0 = a0 + b0, v1 = a1 + b1;
            float ss = (v0.x * v0.x + v0.y * v0.y) + (v0.z * v0.z + v0.w * v0.w) + (v1.x * v1.x + v1.y * v1.y) + (v1.z * v1.z + v1.w * v1.w);
            ss += __shfl_xor(ss, 1); ss += __shfl_xor(ss, 2); ss += __shfl_xor(ss, 4); ss += __shfl_xor(ss, 8);
            const float rn = 1.0f / sqrtf(ss * (1.0f / 128.0f) + 1e-6f);
            const f32x4 g0 = *(const f32x4*)(ggain + c8), g1 = *(const f32x4*)(ggain + c8 + 4);
            const u32x4 gr = *(const u32x4*)(GG + o);
            float gt8[8];
#pragma unroll
            for (int e = 0; e < 4; ++e) { gt8[2 * e] = __builtin_bit_cast(float, gr[e] << 16); gt8[2 * e + 1] = __builtin_bit_cast(float, gr[e] & 0xffff0000u); }
            f32x4 r0, r1;
#pragma unroll
            for (int e = 0; e < 4; ++e) { r0[e] = v0[e] * rn * g0[e] * pg8::silu_f(gt8[e]); r1[e] = v1[e] * rn * g1[e] * pg8::silu_f(gt8[4 + e]); }
            u32x4 w; w.x = pk2(r0[0], r0[1]); w.y = pk2(r0[2], r0[3]); w.z = pk2(r1[0], r1[1]); w.w = pk2(r1[2], r1[3]);
            *(u32x4*)(AO + (size_t)m * DM + hh * 128 + c8) = w;
        }
    }
    SEAM(3);
    if (IN(4)) {
        pg8::Gemm g{AO, W_EOUT, MTOK, DM, DM}; pg8::StaticOrder S; S.init(MTOK, DM, G, bx);
        pg8::EpiResid E{x_in, XF, ALPHA};
        pg8::gemm_phase<pg8::EpiResid, pg8::StaticOrder, true, true>(lds, g, S, E);
    }
    SEAM(4);
    if (IN(5)) {
        for (int m = gw; m < MTOK; m += NGW) { f32x4 v[4];
#pragma unroll
            for (int j = 0; j < 4; ++j) v[j] = *((const f32x4*)(XF + (size_t)m * DM) + lane + 64 * j);
            ln_apply(v, ln_g + 0 * DM, ln_b + 0 * DM, lane); store_row_f32_bf16(v, XF + (size_t)m * DM, XB + (size_t)m * DM, lane); }
    }
    SEAM(5);
    if (IN(6)) {
        pg8::Gemm g{XB, W_FGU, MTOK, FGU_N, DM}; pg8::StaticOrder S; S.init(MTOK, FGU_N, G, bx);
        pg8::EpiSwiglu E{Hb, FGU_N / 256, 0};
        pg8::gemm_phase<pg8::EpiSwiglu, pg8::StaticOrder, true, true>(lds, g, S, E);
    }
    SEAM(6);
    if (IN(7)) {
        pg8::Gemm g{Hb, W_FDN, MTOK, DM, FF}; pg8::StaticOrder S; S.init(MTOK, DM, G, bx);
        pg8::EpiResid E{XF, XF, ALPHA};
        pg8::gemm_phase<pg8::EpiResid, pg8::StaticOrder, true, true>(lds, g, S, E);
    }
    SEAM(7);
    if (IN(8)) {
        for (int m = gw; m < MTOK; m += NGW) { f32x4 v[4];
#pragma unroll
            for (int j = 0; j < 4; ++j) v[j] = *((const f32x4*)(XF + (size_t)m * DM) + lane + 64 * j);
            ln_apply(v, ln_g + 1 * DM, ln_b + 1 * DM, lane); store_row_f32_bf16(v, XF + (size_t)m * DM, XB + (size_t)m * DM, lane); }
    }
    SEAM(8);
    if (IN(9)) {
        pg8::Gemm g{XB, W_OIN, MTOK, OIN_N, DM}; pg8::StaticOrder S; S.init(MTOK, OIN_N, G, bx);
        pg8::EpiOddIn E{CQ, CKV, KR};
        pg8::gemm_phase<pg8::EpiOddIn, pg8::StaticOrder, true, true>(lds, g, S, E);
    }
    SEAM(9);
    if (IN(10)) {
        const float* qg = args.in[I_QGAIN]; const float* kg = args.in[I_KVGAIN];
        for (int m = gw; m < MTOK; m += NGW) {
            const f32x4 cq = *((const f32x4*)(CQ + (size_t)m * 256) + lane);
            float ss = wave_sum((cq.x * cq.x + cq.y * cq.y) + (cq.z * cq.z + cq.w * cq.w));
            float rn = 1.0f / sqrtf(ss * (1.0f / 256.0f) + 1e-6f);
            const f32x4 g4 = *((const f32x4*)qg + lane);
            u32x2 w; w.x = pk2(cq.x * rn * g4.x, cq.y * rn * g4.y); w.y = pk2(cq.z * rn * g4.z, cq.w * rn * g4.w);
            *((u32x2*)(CQN + (size_t)m * 256) + lane) = w;
            const f32x2 ck = *((const f32x2*)(CKV + (size_t)m * 128) + lane);
            ss = wave_sum(ck.x * ck.x + ck.y * ck.y); rn = 1.0f / sqrtf(ss * (1.0f / 128.0f) + 1e-6f);
            const f32x2 g2 = *((const f32x2*)kg + lane);
            *((unsigned*)(CKVN + (size_t)m * 128) + lane) = pk2(ck.x * rn * g2.x, ck.y * rn * g2.y);
            const float val = KR[(size_t)m * 32 + (lane & 31)]; const float partner = __shfl_xor(val, 16);
            const int pos = m & (SEQ - 1), i = lane & 15; const float cs = ROPE[(pos * 16 + i) * 2], sn = ROPE[(pos * 16 + i) * 2 + 1];
            const float o = (lane & 16) ? (partner * sn + val * cs) : (val * cs - partner * sn);
            if (lane < 32) { const bf16 ob = (bf16)f2bf(o); bf16* kp = Kb + (size_t)m * 1536 + 64 + lane;
#pragma unroll
                for (int h = 0; h < 16; ++h) kp[h * 96] = ob; }
        }
    }
    SEAM(10);
    if (IN(11)) {
#ifndef SKIP_QUP
        { int kq = 256; asm volatile("" : "+s"(kq)); pg8::Gemm g{CQN, W_UQ, MTOK, UQ_N, kq}; pg8::StaticOrder S; S.init(MTOK, UQ_N, G, bx);
          pg8::EpiQUp E{Qb, ROPE, 0.10206207261596575f * LOG2E};
          pg8::gemm_phase<pg8::EpiQUp, pg8::StaticOrder, true, true>(lds, g, S, E); }
#endif
        __syncthreads();
#ifndef SKIP_KVUP
        { int kk = 128; asm volatile("" : "+s"(kk)); pg8::Gemm g{CKVN, W_UKV, MTOK, UKV_N, kk}; pg8::StaticOrder S; S.init(MTOK, UKV_N, G, bx);
          pg8::EpiKvUp E{Kb, VTb};
          pg8::gemm_phase<pg8::EpiKvUp, pg8::StaticOrder, true, true>(lds, g, S, E); }
#endif
    }
    SEAM(11);
    if (IN(12)) {
        const AttnP AP{Qb, Kb, VTb, AO2, nullptr, nullptr, nullptr};
        attn_phase<false>(lds, AP, G, bx, nullptr);
    }
    SEAM(12);
    if (IN(13)) {
        pg8::Gemm g{AO2, W_OOUT, MTOK, DM, DM}; pg8::StaticOrder S; S.init(MTOK, DM, G, bx);
        pg8::EpiResid E{XF, XF, ALPHA};
        pg8::gemm_phase<pg8::EpiResid, pg8::StaticOrder, true, true>(lds, g, S, E);
    }
    SEAM(13);
    if (IN(14)) {
        LAS int* cntL = (LAS int*)lds; const float* rw = args.in[I_ROUTER];
        for (int ch = bx; ch < MTOK / 64; ch += G) {
            if (tid < 8) cntL[tid] = 0;
            __syncthreads();
            for (int i = 0; i < 8; ++i) { const int m = 64 * ch + 8 * wave + i; f32x4 v[4];
#pragma unroll
                for (int j = 0; j < 4; ++j) v[j] = *((const f32x4*)(XF + (size_t)m * DM) + lane + 64 * j);
                ln_apply(v, ln_g + 2 * DM, ln_b + 2 * DM, lane); store_row_f32_bf16(v, XF + (size_t)m * DM, XB + (size_t)m * DM, lane);
                float lg[8];
#pragma unroll
                for (int e = 0; e < 8; ++e) lg[e] = 0.f;
#pragma unroll
                for (int j = 0; j < 4; ++j)
#pragma unroll
                    for (int e4 = 0; e4 < 4; ++e4) { const int d = 256 * j + 4 * lane + e4; const f32x4 r0 = *(const f32x4*)(rw + (size_t)d * 8), r1 = *(const f32x4*)(rw + (size_t)d * 8 + 4); const float xv = v[j][e4];
#pragma unroll
                        for (int e = 0; e < 4; ++e) { lg[e] += xv * r0[e]; lg[4 + e] += xv * r1[e]; } }
#pragma unroll
                for (int e = 0; e < 8; ++e) lg[e] = wave_sum(lg[e]);
                int e0 = 0; float v0 = lg[0];
#pragma unroll
                for (int e = 1; e < 8; ++e) if (lg[e] > v0) { v0 = lg[e]; e0 = e; }
                int e1 = -1; float v1 = -3.0e38f;
#pragma unroll
                for (int e = 0; e < 8; ++e) if (e != e0 && lg[e] > v1) { v1 = lg[e]; e1 = e; }
                const float w0 = 1.0f / (1.0f + __expf(v1 - v0)), w1 = 1.0f - w0;
                if (lane == 0) { TOKE[2 * m] = e0; TOKE[2 * m + 1] = e1; TOKW[2 * m] = w0; TOKW[2 * m + 1] = w1; atomicAdd((int*)(cntL + e0), 1); atomicAdd((int*)(cntL + e1), 1); }
            }
            __syncthreads();
            if (tid < 8) BLKCNT[ch * 8 + tid] = cntL[tid];
            __syncthreads();
        }
    }
    SEAM(14);
    if (IN(15)) {
        LAS int* cnt_all = (LAS int*)lds; LAS int* pre = cnt_all + 2048; LAS int* segb = pre + 8; LAS int* w0cnt = segb + 8; LAS int* posL = w0cnt + 8; LAS int* tot = posL + 128;
        for (int i = tid; i < 2048; i += NTHR) cnt_all[i] = BLKCNT[i];
        __syncthreads();
        if (tid < 8) { int s = 0; for (int c2 = 0; c2 < 256; ++c2) s += cnt_all[c2 * 8 + tid]; tot[tid] = s; }
        __syncthreads();
        if (tid == 0) { int rowb = 0; for (int e = 0; e < 8; ++e) { segb[e] = rowb; rowb += ((tot[e] + 255) >> 8) << 8; }
            if (bx == 0) { int t = 0; for (int e = 0; e < 8; ++e) { const int nt = (tot[e] + 255) >> 8; for (int k = 0; k < nt; ++k) TILEE[t++] = e; } TILEE[MAXT] = t; } }
        __syncthreads();
        for (int ch = bx; ch < MTOK / 64; ch += G) {
            if (tid < 8) { int s = 0; for (int c2 = 0; c2 < ch; ++c2) s += cnt_all[c2 * 8 + tid]; pre[tid] = s; }
            int e_mine = -1, rank = 0, token = 0, kk = 0;
            if (tid < 128) { token = 64 * ch + (tid >> 1); kk = tid & 1; e_mine = TOKE[2 * token + kk]; }
            if (wave < 2) {
#pragma unroll
                for (int e = 0; e < 8; ++e) { const unsigned long long mask = __ballot(e_mine == e); if (e_mine == e) rank = __popcll(mask & ((1ull << lane) - 1ull)); if (wave == 0 && lane == 0) w0cnt[e] = __popcll(mask); }
            }
            __syncthreads();
            if (tid < 128) { if (wave == 1) rank += w0cnt[e_mine]; const int pos = segb[e_mine] + pre[e_mine] + rank; posL[tid] = pos; POS[2 * token + kk] = pos; }
            __syncthreads();
            for (int en = wave; en < 128; en += 8) { const int tk = 64 * ch + (en >> 1); const int pos = posL[en];
                const u32x4* src = (const u32x4*)(XB + (size_t)tk * DM); u32x4* dst = (u32x4*)(XP + (size_t)pos * DM);
                const u32x4 a = src[lane], b2 = src[lane + 64]; dst[lane] = a; dst[lane + 64] = b2; }
            __syncthreads();
        }
    }
    SEAM(15);
#define MOE_GU(ph, PASS) if (IN(ph)) { const int T = TILEE[MAXT], T1 = (T + 1) >> 1; const int t0 = (PASS) ? T1 : 0, t1 = (PASS) ? T : T1; \
        pg8::Gemm g{XP, W_MGU, 0, 0, DM}; pg8::MoeOrder S{t0, t1, FGU_N / 256, G, bx, FGU_N / 256, 0, TILEE}; pg8::EpiSwiglu E{HP, FGU_N / 256, t0}; \
        pg8::gemm_phase<pg8::EpiSwiglu, pg8::MoeOrder, true, true>(lds, g, S, E); }
#define MOE_DN(ph, PASS) if (IN(ph)) { const int T = TILEE[MAXT], T1 = (T + 1) >> 1; const int t0 = (PASS) ? T1 : 0, t1 = (PASS) ? T : T1; \
        pg8::Gemm g{HP, W_MDN, 0, 0, FF}; pg8::MoeOrder S{t0, t1, 4, G, bx, 4, t0, TILEE}; pg8::EpiBf16Out E{XP, t0}; \
        pg8::gemm_phase<pg8::EpiBf16Out, pg8::MoeOrder, true, true>(lds, g, S, E); }
    MOE_GU(16, 0) SEAM(16);
    MOE_DN(17, 0) SEAM(17);
    MOE_GU(18, 1) SEAM(18);
    MOE_DN(19, 1) SEAM(19);
    if (IN(20)) {
        for (int m = gw; m < MTOK; m += NGW) {
            const int p0 = POS[2 * m], p1 = POS[2 * m + 1]; const float w0 = TOKW[2 * m], w1 = TOKW[2 * m + 1];
            f32x4 v[4];
#pragma unroll
            for (int j = 0; j < 4; ++j) { const f32x4 xv = *((const f32x4*)(XF + (size_t)m * DM) + lane + 64 * j);
                const u32x2 y0 = *((const u32x2*)(XP + (size_t)p0 * DM) + lane + 64 * j), y1 = *((const u32x2*)(XP + (size_t)p1 * DM) + lane + 64 * j);
                f32x4 a, b2; a.x = __builtin_bit_cast(float, y0.x << 16); a.y = __builtin_bit_cast(float, y0.x & 0xffff0000u); a.z = __builtin_bit_cast(float, y0.y << 16); a.w = __builtin_bit_cast(float, y0.y & 0xffff0000u);
                b2.x = __builtin_bit_cast(float, y1.x << 16); b2.y = __builtin_bit_cast(float, y1.x & 0xffff0000u); b2.z = __builtin_bit_cast(float, y1.y << 16); b2.w = __builtin_bit_cast(float, y1.y & 0xffff0000u);
                v[j] = xv * ALPHA + a * w0 + b2 * w1; }
            ln_apply(v, ln_g + 3 * DM, ln_b + 3 * DM, lane);
            GAS f32x4* fr = (GAS f32x4*)(XF + (size_t)m * DM) + lane;
#pragma unroll
            for (int j = 0; j < 4; ++j) fr[64 * j] = v[j];
        }
    }
#undef IN
#undef SEAM
}

extern "C" void kernel_launch(void* const* d_in, const int* in_sizes, int n_in, void* d_out, int out_size, void* d_ws, size_t ws_size, hipStream_t stream) {
    static int grid = 0;
    if (grid == 0) {
        if (n_in != 24 || out_size != MTOK * DM || ws_size < WS_END) { fprintf(stderr, "kernel_launch: unexpected problem (n_in %d, out %d, ws %zu)\n", n_in, out_size, ws_size); grid = -1; return; }
        int dev = 0, cus = 0, per_cu = 0;
        if (hipGetDevice(&dev) != hipSuccess || hipDeviceGetAttribute(&cus, hipDeviceAttributeMultiprocessorCount, dev) != hipSuccess) { grid = -1; return; }
        if (hipFuncSetAttribute((const void*)mega_fwd, hipFuncAttributeMaxDynamicSharedMemorySize, LDS_BYTES) != hipSuccess) { fprintf(stderr, "kernel_launch: hipFuncSetAttribute failed\n"); grid = -1; return; }
        if (hipOccupancyMaxActiveBlocksPerMultiprocessor(&per_cu, (const void*)mega_fwd, NTHR, LDS_BYTES) != hipSuccess || per_cu < 1) { fprintf(stderr, "kernel_launch: occupancy query says %d\n", per_cu); }
        (void)hipGetLastError();
        grid = cus;
    }
    if (grid < 0) return;
    if (hipMemsetAsync((char*)d_ws + WS_CTL, 0, CTL_ZERO_BYTES, stream) != hipSuccess) return;
    Args a{};
    for (int i = 0; i < 24; ++i) a.in[i] = (const float*)d_in[i];
    a.out = (float*)d_out; a.ws = (unsigned char*)d_ws;
#if MK_PER_PHASE
    for (int p = 0; p < NPHASE; ++p) { a.ph_lo = p; a.ph_hi = p + 1; a.flags = 0; hipLaunchKernelGGL(mega_fwd, dim3(grid), dim3(NTHR), LDS_BYTES, stream, a);
#ifdef PROBE_REP
        if (p == PROBE_REP) for (int rr = 0; rr < PROBE_N; ++rr) { a.flags = PROBE_FLAGS; hipLaunchKernelGGL(mega_fwd, dim3(grid), dim3(NTHR), LDS_BYTES, stream, a); }
#endif
    }
#else
    a.ph_lo = 0; a.ph_hi = NPHASE; hipLaunchKernelGGL(mega_fwd, dim3(grid), dim3(NTHR), LDS_BYTES, stream, a);
#endif
}
```

```cpp
#include <hip/hip_runtime.h>
#include <cstdio>
#include <cstdint>
namespace pg8 {
#define PG8_LAS __attribute__((address_space(3)))
typedef unsigned short bf16_t;
typedef short bf16x8 __attribute__((ext_vector_type(8)));
typedef float f32x4 __attribute__((ext_vector_type(4)));
typedef unsigned u32x4 __attribute__((ext_vector_type(4)));
constexpr int BM = 256, BK = 64, HALF = 128, HTB = HALF * BK * 2  , STAGE_BYTES = 8 * HTB, NXCD = 8, WGM = 8;

__host__ __device__ __forceinline__ int lds_byte(int r, int c) { const int st = (r >> 4) * 2 + (c >> 5), rr = r & 15, cc = c & 31, ob = rr * 64 + cc * 2; return st * 1024 + (ob ^ (((ob >> 9) & 1) << 5)); }
__host__ __device__ __forceinline__ void stage_rc(int b, int& R, int& C) { const int st = b / 1024, sb = b % 1024, swz = sb ^ (((sb >> 9) & 1) << 5); R = (st >> 1) * 16 + swz / 64; C = (st & 1) * 32 + (swz % 64) / 2; }
__host__ __device__ __forceinline__ int perm32(int rho) { const int n = rho >> 4, i = rho & 15; return 8 * (i >> 2) + 4 * n + (i & 3); }

struct Unit { int pm, pn; };
struct Gemm { const bf16_t* A; const bf16_t* Bt; int M, N, K; };

struct StaticOrder {
    int nM, nN, nwg, G, c;
    __host__ __device__ void init(int M, int N, int G_, int c_) { nM = M / BM; nN = N / BM; nwg = nM * nN; G = G_; c = c_; }
    __host__ __device__ bool next(int i, Unit& u) const {
        const long L = (long)i * G + c; if (L >= nwg) return false;
        int wgid = (int)L; { const int q = nwg / NXCD, r = nwg % NXCD, xcd = wgid % NXCD, off = wgid / NXCD; wgid = (xcd < r ? xcd * (q + 1) : r * (q + 1) + (xcd - r) * q) + off; }
        const int nig = WGM * nN, gid = wgid / nig, fm = gid * WGM, gsz = (nM - fm) < WGM ? (nM - fm) : WGM;
        u.pm = fm + ((wgid % nig) % gsz); u.pn = (wgid % nig) / gsz; return true;
    }
    __device__ __forceinline__ void a_ready(const Unit&) const {}
    __device__ __forceinline__ void done(const Unit&) const {}
};

__device__ __forceinline__ unsigned cvt_pk_bf16(float lo, float hi) { unsigned r; asm volatile("v_cvt_pk_bf16_f32 %0, %1, %2" : "=v"(r) : "v"(lo), "v"(hi)); return r; }
typedef float f32x2 __attribute__((ext_vector_type(2)));
typedef unsigned u32x2 __attribute__((ext_vector_type(2)));
__device__ __forceinline__ unsigned f2bf_rne(float f) { unsigned u = __builtin_bit_cast(unsigned, f); return (u + 0x7fffu + ((u >> 16) & 1u)) >> 16; }
__device__ __forceinline__ float silu_f(float g) { return g * __builtin_amdgcn_rcpf(1.0f + __expf(-g)); }
__device__ __forceinline__ u32x4 pack8(const f32x4 v0, const f32x4 v1) { u32x4 w; w.x = cvt_pk_bf16(v0[0], v0[1]); w.y = cvt_pk_bf16(v0[2], v0[3]); w.z = cvt_pk_bf16(v1[0], v1[1]); w.w = cvt_pk_bf16(v1[2], v1[3]); return w; }

struct EpiEvenIn {
    static constexpr bool PERM = true, AFTER_DRAIN = false;
    bf16_t *QG, *KG, *VGT, *GG, *QD, *KD, *VDT;
    __device__ __forceinline__ void operator()(const f32x4 (&acc)[2][2][4][2], const Unit& u, int wr, int wc, int fr, int fq) const {
        const int pn = u.pn; const int row0 = u.pm * BM + wr * 64 + fr; const int cl = wc * 32 + 8 * fq;
        if (pn < 10 && (pn & ~1) != 2) {
            bf16_t* base; int ld, c0; float sc = 1.f;
            if (pn == 0) { base = QG; ld = 256; c0 = 0; sc = 0.125f; }
            else if (pn == 1) { base = KG; ld = 256; c0 = 0; }
            else if (pn < 6) { base = GG; ld = 512; c0 = (pn - 4) * 256; }
            else if (pn < 8) { base = QD; ld = 512; c0 = (pn - 6) * 256; sc = 0.125f * 1.4426950408889634f; }
            else { base = KD; ld = 512; c0 = (pn - 8) * 256; }
#pragma unroll
            for (int ai = 0; ai < 2; ++ai)
#pragma unroll
                for (int m = 0; m < 4; ++m) { bf16_t* rowp = base + (size_t)(row0 + ai * HALF + m * 16) * ld + c0 + cl;
#pragma unroll
                    for (int bj = 0; bj < 2; ++bj) *(u32x4*)(rowp + bj * HALF) = pack8(acc[ai][bj][m][0] * sc, acc[ai][bj][m][1] * sc); }
        } else if (pn < 12) {
            const int b = row0 >> 11, s0 = row0 & 2047;
            bf16_t* vbase = pn < 4 ? VGT : VDT; const int hb = pn < 4 ? 2 * (pn - 2) : 2 * (pn - 10);
#pragma unroll
            for (int bj = 0; bj < 2; ++bj) { bf16_t* vp0 = vbase + ((size_t)(b * 4 + hb + bj) * 128 + cl) * 2048 + s0;
#pragma unroll
                for (int n = 0; n < 2; ++n)
#pragma unroll
                    for (int e = 0; e < 4; ++e) { bf16_t* vp = vp0 + (size_t)(4 * n + e) * 2048;
#pragma unroll
                        for (int ai = 0; ai < 2; ++ai)
#pragma unroll
                            for (int m = 0; m < 4; ++m) vp[ai * HALF + m * 16] = (bf16_t)f2bf_rne(acc[ai][bj][m][n][e]); } }
        }
    }
};
struct EpiResid {
    static constexpr bool PERM = false, AFTER_DRAIN = false;
    const float* base; float* out; float alpha;
    __device__ __forceinline__ void operator()(const f32x4 (&acc)[2][2][4][2], const Unit& u, int wr, int wc, int fr, int fq) const {
        const int col0 = u.pn * BM + wc * 32 + 4 * fq;
#pragma unroll
        for (int ai = 0; ai < 2; ++ai)
#pragma unroll
            for (int m = 0; m < 4; ++m) { const size_t off = (size_t)(u.pm * BM + ai * HALF + wr * 64 + m * 16 + fr) * 1024 + col0;
#pragma unroll
                for (int bj = 0; bj < 2; ++bj)
#pragma unroll
                    for (int n = 0; n < 2; ++n) { const size_t p = off + bj * HALF + n * 16; const f32x4 bs = *(const f32x4*)(base + p); *(f32x4*)(out + p) = bs * alpha + acc[ai][bj][m][n]; } }
    }
};
struct EpiSwiglu {
    static constexpr bool PERM = true, AFTER_DRAIN = false;
    bf16_t* H; int ncol, pm_off;
    __device__ __forceinline__ void operator()(const f32x4 (&acc)[2][2][4][2], const Unit& u, int wr, int wc, int fr, int fq) const {
        const int pnl = u.pn % ncol; const int rowb = (u.pm - pm_off) * BM + wr * 64 + fr; const int col = pnl * 128 + wc * 32 + 8 * fq;
#pragma unroll
        for (int ai = 0; ai < 2; ++ai)
#pragma unroll
            for (int m = 0; m < 4; ++m) { bf16_t* rowp = H + (size_t)(rowb + ai * HALF + m * 16) * 2816 + col;
                f32x4 h0, h1;
#pragma unroll
                for (int e = 0; e < 4; ++e) { h0[e] = silu_f(acc[ai][0][m][0][e]) * acc[ai][1][m][0][e]; h1[e] = silu_f(acc[ai][0][m][1][e]) * acc[ai][1][m][1][e]; }
                *(u32x4*)rowp = pack8(h0, h1); }
    }
};
struct EpiBf16Out {
    static constexpr bool PERM = true, AFTER_DRAIN = false;
    bf16_t* Y; int pm_add;
    __device__ __forceinline__ void operator()(const f32x4 (&acc)[2][2][4][2], const Unit& u, int wr, int wc, int fr, int fq) const {
        const int pnl = u.pn & 3; const int rowb = (u.pm + pm_add) * BM + wr * 64 + fr; const int col = pnl * BM + wc * 32 + 8 * fq;
#pragma unroll
        for (int ai = 0; ai < 2; ++ai)
#pragma unroll
            for (int m = 0; m < 4; ++m) { bf16_t* rowp = Y + (size_t)(rowb + ai * HALF + m * 16) * 1024 + col;
#pragma unroll
                for (int bj = 0; bj < 2; ++bj) *(u32x4*)(rowp + bj * HALF) = pack8(acc[ai][bj][m][0], acc[ai][bj][m][1]); }
    }
};
struct EpiOddIn {
    static constexpr bool PERM = false, AFTER_DRAIN = false;
    float *CQ, *CKV, *KR;
    __device__ __forceinline__ void operator()(const f32x4 (&acc)[2][2][4][2], const Unit& u, int wr, int wc, int fr, int fq) const {
        const size_t row0 = (size_t)(u.pm * BM + wr * 64 + fr);
        if (u.pn == 0) {
#pragma unroll
            for (int ai = 0; ai < 2; ++ai)
#pragma unroll
                for (int m = 0; m < 4; ++m)
#pragma unroll
                    for (int bj = 0; bj < 2; ++bj)
#pragma unroll
                        for (int n = 0; n < 2; ++n) *(f32x4*)(CQ + (row0 + ai * HALF + m * 16) * 256 + bj * HALF + wc * 32 + n * 16 + 4 * fq) = acc[ai][bj][m][n];
        } else {
#pragma unroll
            for (int ai = 0; ai < 2; ++ai)
#pragma unroll
                for (int m = 0; m < 4; ++m)
#pragma unroll
                    for (int n = 0; n < 2; ++n) *(f32x4*)(CKV + (row0 + ai * HALF + m * 16) * 128 + wc * 32 + n * 16 + 4 * fq) = acc[ai][0][m][n];
            if (wc == 0) {
#pragma unroll
                for (int ai = 0; ai < 2; ++ai)
#pragma unroll
                    for (int m = 0; m < 4; ++m)
#pragma unroll
                        for (int n = 0; n < 2; ++n) *(f32x4*)(KR + (row0 + ai * HALF + m * 16) * 32 + n * 16 + 4 * fq) = acc[ai][1][m][n];
            }
        }
    }
};
struct EpiQUp {
    static constexpr bool PERM = false, AFTER_DRAIN = false;
    bf16_t* Q; const float* rope; float qs;
    __device__ __forceinline__ void operator()(const f32x4 (&acc)[2][2][4][2], const Unit& u, int wr, int wc, int fr, int fq) const {
        const int row0 = u.pm * BM + wr * 64 + fr;
#pragma unroll
        for (int bj = 0; bj < 2; ++bj) { const int G = u.pn * 8 + bj * 4 + wc; bf16_t* colp = Q + G * 32 + 4 * fq;
            if ((G % 3) != 2) {
#pragma unroll
                for (int ai = 0; ai < 2; ++ai)
#pragma unroll
                    for (int m = 0; m < 4; ++m) { bf16_t* rowp = colp + (size_t)(row0 + ai * HALF + m * 16) * 1536;
                        const f32x4 a0 = acc[ai][bj][m][0] * qs, a1 = acc[ai][bj][m][1] * qs;
                        u32x2 w0, w1; w0.x = cvt_pk_bf16(a0[0], a0[1]); w0.y = cvt_pk_bf16(a0[2], a0[3]); w1.x = cvt_pk_bf16(a1[0], a1[1]); w1.y = cvt_pk_bf16(a1[2], a1[3]);
                        *(u32x2*)rowp = w0; *(u32x2*)(rowp + 16) = w1; }
            } else {
#pragma unroll
                for (int ai = 0; ai < 2; ++ai)
#pragma unroll
                    for (int m = 0; m < 4; ++m) { const int row = row0 + ai * HALF + m * 16; bf16_t* rowp = colp + (size_t)row * 1536;
                        const int pos = row & 2047; const f32x4* rp = (const f32x4*)(rope + (size_t)pos * 32 + 8 * fq); const f32x4 t0 = rp[0], t1 = rp[1];
                        const f32x4 cs = (f32x4){t0[0], t0[2], t1[0], t1[2]} * qs, sn = (f32x4){t0[1], t0[3], t1[1], t1[3]} * qs;
                        const f32x4 a0 = acc[ai][bj][m][0] * cs - acc[ai][bj][m][1] * sn, a1 = acc[ai][bj][m][0] * sn + acc[ai][bj][m][1] * cs;
                        u32x2 w0, w1; w0.x = cvt_pk_bf16(a0[0], a0[1]); w0.y = cvt_pk_bf16(a0[2], a0[3]); w1.x = cvt_pk_bf16(a1[0], a1[1]); w1.y = cvt_pk_bf16(a1[2], a1[3]);
                        *(u32x2*)rowp = w0; *(u32x2*)(rowp + 16) = w1;
                        asm volatile("" ::: "memory"); }
            } }
    }
};
struct EpiKvUp {
    static constexpr bool PERM = true, AFTER_DRAIN = false;
    bf16_t *K, *VT;
    __device__ __forceinline__ void operator()(const f32x4 (&acc)[2][2][4][2], const Unit& u, int wr, int wc, int fr, int fq) const {
        const int row0 = u.pm * BM + wr * 64 + fr;
        if (wc < 2) {
#pragma unroll
            for (int bj = 0; bj < 2; ++bj) { bf16_t* colp = K + (2 * u.pn + bj) * 96 + wc * 32 + 8 * fq;
#pragma unroll
                for (int ai = 0; ai < 2; ++ai)
#pragma unroll
                    for (int m = 0; m < 4; ++m) *(u32x4*)(colp + (size_t)(row0 + ai * HALF + m * 16) * 1536) = pack8(acc[ai][bj][m][0], acc[ai][bj][m][1]); }
        } else {
            const int b = row0 >> 11, s0 = row0 & 2047;
#pragma unroll
            for (int bj = 0; bj < 2; ++bj) { bf16_t* vp0 = VT + ((size_t)(b * 16 + 2 * u.pn + bj) * 64 + (wc - 2) * 32 + 8 * fq) * 2048 + s0;
#pragma unroll
                for (int n = 0; n < 2; ++n)
#pragma unroll
                    for (int e = 0; e < 4; ++e) { bf16_t* vp = vp0 + (size_t)(4 * n + e) * 2048;
#pragma unroll
                        for (int ai = 0; ai < 2; ++ai)
#pragma unroll
                            for (int m = 0; m < 4; ++m) vp[ai * HALF + m * 16] = (bf16_t)f2bf_rne(acc[ai][bj][m][n][e]); } }
        }
    }
};
struct MoeOrder {
    int t0, t1, ncol, G, c, bstride, pm_sub; const int* tile_e;
    __device__ __forceinline__ bool next(int i, Unit& u) const {
        const int L = i * G + c; if (L >= (t1 - t0) * ncol) return false;
        const int tile = t0 + L / ncol, pn = L % ncol;
        u.pm = tile - pm_sub; u.pn = tile_e[tile] * bstride + pn; return true;
    }
    __device__ __forceinline__ void a_ready(const Unit&) const {}
    __device__ __forceinline__ void done(const Unit&) const {}
};

template <class Epi, class Sched, bool ALIGN_EPI = false, bool SP2 = false>
__device__ __forceinline__ void gemm_phase(PG8_LAS unsigned char* lds, const Gemm g, const Sched& S, const Epi& E) {
    const int tid = threadIdx.x, wid = __builtin_amdgcn_readfirstlane(tid >> 6), lane = tid & 63, wr = wid >> 2, wc = wid & 3, fr = lane & 15, fq = lane >> 4;
    const int K = g.K, nt = K / BK;
    unsigned voffA[2], voffB[2];
#pragma unroll
    for (int i = 0; i < 2; ++i) { int R, C; stage_rc(tid * 16 + i * 8192, R, C); const int Rb = Epi::PERM ? ((R & ~31) + perm32(R & 31)) : R;
        voffA[i] = (unsigned)(R * K + C) * 2u; voffB[i] = (unsigned)(Rb * K + C) * 2u; }
    const size_t kstep = (size_t)(BK * 2);
    const size_t hstep = (size_t)HALF * K * 2;
    const size_t tstep = 2 * hstep;
    const unsigned ldsw = (unsigned)wid * 1024u;
    const int aoff = lds_byte(wr * 64 + fr, fq * 8), boff = lds_byte(wc * 32 + fr, fq * 8);
#define PG8_SA(b, h) (((b) * 2 + (h)) * HTB)
#define PG8_SB(b, h) ((4 + (b) * 2 + (h)) * HTB)
#define PG8_STAGE(bufoff, gbase, voff) do { _Pragma("unroll") for (int _i = 0; _i < 2; ++_i) \
        __builtin_amdgcn_global_load_lds((const unsigned*)((const char*)(gbase) + (voff)[_i]), (PG8_LAS unsigned*)(lds + (bufoff) + ldsw + _i * 8192), 16, 0, 0); } while (0)
#define PG8_LDA(dst, b, h) do { _Pragma("unroll") for (int m = 0; m < 4; ++m) _Pragma("unroll") for (int k = 0; k < 2; ++k) dst[m][k] = *(const PG8_LAS bf16x8*)(lds + PG8_SA(b, h) + aoff + m * 2048 + k * 1024); } while (0)
#define PG8_LDB(dst, b, h) do { _Pragma("unroll") for (int n = 0; n < 2; ++n) _Pragma("unroll") for (int k = 0; k < 2; ++k) dst[n][k] = *(const PG8_LAS bf16x8*)(lds + PG8_SB(b, h) + boff + n * 2048 + k * 1024); } while (0)
#define PG8_MMA(ai, bj, At, Bt) do { __builtin_amdgcn_s_setprio(1); _Pragma("unroll") for (int m = 0; m < 4; ++m) _Pragma("unroll") for (int n = 0; n < 2; ++n) _Pragma("unroll") for (int k = 0; k < 2; ++k) \
        acc[ai][bj][m][n] = __builtin_amdgcn_mfma_f32_16x16x32_bf16(Bt[n][k], At[m][k], acc[ai][bj][m][n], 0, 0, 0); __builtin_amdgcn_s_setprio(0); } while (0)
#define PG8_WAIT_V(n) asm volatile("s_waitcnt vmcnt(" #n ")" ::: "memory")
#define PG8_WAIT_L(n) asm volatile("s_waitcnt lgkmcnt(" #n ")" ::: "memory")
#define PG8_BAR __builtin_amdgcn_s_barrier()
#define PG8_SCHED __builtin_amdgcn_sched_barrier(0)
    Unit cur, nxt; int ui = 0;
    if (!S.next(0, cur)) return;
    f32x4 acc[2][2][4][2];
#pragma unroll
    for (int a = 0; a < 2; ++a)
#pragma unroll
        for (int b = 0; b < 2; ++b)
#pragma unroll
            for (int m = 0; m < 4; ++m)
#pragma unroll
                for (int n = 0; n < 2; ++n) acc[a][b][m][n] = (f32x4){0.f, 0.f, 0.f, 0.f};
    bf16x8 At[4][2], B0[2][2], B1[2][2];
    const char* cA = (const char*)g.A + (size_t)cur.pm * tstep; const char* cB = (const char*)g.Bt + (size_t)cur.pn * tstep;
    S.a_ready(cur);
    if constexpr (SP2) {
        PG8_STAGE(PG8_SB(0, 0), cB, voffB); PG8_STAGE(PG8_SB(0, 1), cB + hstep, voffB); PG8_STAGE(PG8_SA(0, 0), cA, voffA); PG8_STAGE(PG8_SA(0, 1), cA + hstep, voffA);
        if (wr == 1) PG8_BAR;
        PG8_WAIT_V(2); PG8_BAR;
        PG8_STAGE(PG8_SB(1, 0), cB + kstep, voffB); PG8_STAGE(PG8_SA(1, 0), cA + kstep, voffA); PG8_STAGE(PG8_SB(1, 1), cB + hstep + kstep, voffB);
        PG8_WAIT_V(6); PG8_BAR;
    } else {
        PG8_STAGE(PG8_SB(0, 0), cB, voffB); PG8_STAGE(PG8_SA(0, 0), cA, voffA); PG8_STAGE(PG8_SB(0, 1), cB + hstep, voffB); PG8_STAGE(PG8_SA(0, 1), cA + hstep, voffA);
        if (wr == 1) PG8_BAR;
        PG8_WAIT_V(4); PG8_BAR;
        PG8_STAGE(PG8_SB(1, 0), cB + kstep, voffB); PG8_STAGE(PG8_SA(1, 0), cA + kstep, voffA); PG8_STAGE(PG8_SB(1, 1), cB + hstep + kstep, voffB);
        PG8_WAIT_V(6); PG8_BAR;
    }
    for (;;) {
        const bool has_next = S.next(ui + 1, nxt);
        const char* nA = has_next ? (const char*)g.A + (size_t)nxt.pm * tstep : cA; const char* nB = has_next ? (const char*)g.Bt + (size_t)nxt.pn * tstep : cB;
        for (int t = 0; t < nt; t += 2) {
            const bool last = (t == nt - 2);
            const char* a1 = cA + (size_t)(t + 1) * kstep;
            const char* a2 = last ? nA : cA + (size_t)(t + 2) * kstep; const char* b2 = last ? nB : cB + (size_t)(t + 2) * kstep;
            const char* a3 = a2 + kstep; const char* b3 = b2 + kstep;
            if (last && has_next) S.a_ready(nxt);
            if constexpr (SP2) {
            PG8_LDB(B0, 0, 0); PG8_LDB(B1, 0, 1); PG8_SCHED; PG8_LDA(At, 0, 0); PG8_STAGE(PG8_SA(1, 1), a1 + hstep, voffA);
            PG8_WAIT_V(8); PG8_WAIT_L(0); PG8_BAR; PG8_MMA(0, 0, At, B0); PG8_MMA(0, 1, At, B1); PG8_BAR; PG8_SCHED;
            PG8_LDA(At, 0, 1); PG8_STAGE(PG8_SB(0, 0), b2, voffB); PG8_STAGE(PG8_SB(0, 1), b2 + hstep, voffB); PG8_STAGE(PG8_SA(0, 0), a2, voffA);
            PG8_WAIT_V(8); PG8_WAIT_L(0); PG8_BAR; PG8_MMA(1, 0, At, B0); PG8_MMA(1, 1, At, B1); PG8_BAR; PG8_SCHED;
            PG8_LDB(B0, 1, 0); PG8_LDB(B1, 1, 1); PG8_SCHED; PG8_LDA(At, 1, 0); PG8_STAGE(PG8_SA(0, 1), a2 + hstep, voffA);
            PG8_WAIT_V(8); PG8_WAIT_L(0); PG8_BAR; PG8_MMA(0, 0, At, B0); PG8_MMA(0, 1, At, B1); PG8_BAR; PG8_SCHED;
            PG8_LDA(At, 1, 1); PG8_STAGE(PG8_SB(1, 0), b3, voffB); PG8_STAGE(PG8_SB(1, 1), b3 + hstep, voffB); PG8_STAGE(PG8_SA(1, 0), a3, voffA);
            PG8_WAIT_V(8); PG8_WAIT_L(0); PG8_BAR; PG8_MMA(1, 0, At, B0); PG8_MMA(1, 1, At, B1); PG8_BAR; PG8_SCHED;
            } else {
            PG8_LDB(B0, 0, 0); PG8_SCHED; PG8_LDA(At, 0, 0); PG8_STAGE(PG8_SA(1, 1), a1 + hstep, voffA);
            PG8_WAIT_L(8); PG8_BAR; PG8_WAIT_L(0); PG8_MMA(0, 0, At, B0); PG8_BAR; PG8_SCHED;
            PG8_LDB(B1, 0, 1); PG8_STAGE(PG8_SB(0, 0), b2, voffB);
            PG8_BAR; PG8_WAIT_L(0); PG8_MMA(0, 1, At, B1); PG8_BAR;
            PG8_LDA(At, 0, 1); PG8_STAGE(PG8_SA(0, 0), a2, voffA);
            PG8_BAR; PG8_WAIT_L(0); PG8_MMA(1, 0, At, B0); PG8_BAR; PG8_SCHED;
            PG8_STAGE(PG8_SB(0, 1), b2 + hstep, voffB);
            PG8_WAIT_V(6); PG8_BAR; PG8_MMA(1, 1, At, B1); PG8_BAR;
            PG8_LDB(B0, 1, 0); PG8_SCHED; PG8_LDA(At, 1, 0); PG8_STAGE(PG8_SA(0, 1), a2 + hstep, voffA);
            PG8_WAIT_L(8); PG8_BAR; PG8_WAIT_L(0); PG8_MMA(0, 0, At, B0); PG8_BAR; PG8_SCHED;
            PG8_LDB(B1, 1, 1); PG8_STAGE(PG8_SB(1, 0), b3, voffB);
            PG8_BAR; PG8_WAIT_L(0); PG8_MMA(0, 1, At, B1); PG8_BAR;
            PG8_LDA(At, 1, 1); PG8_STAGE(PG8_SA(1, 0), a3, voffA);
            PG8_BAR; PG8_WAIT_L(0); PG8_MMA(1, 0, At, B0); PG8_BAR; PG8_SCHED;
            PG8_STAGE(PG8_SB(1, 1), b3 + hstep, voffB);
            PG8_WAIT_V(6); PG8_BAR; PG8_MMA(1, 1, At, B1); PG8_BAR;
            }
        }
        if constexpr (ALIGN_EPI) { if (wr == 0) PG8_BAR; }
        if constexpr (!Epi::AFTER_DRAIN) { E(acc, cur, wr, wc, fr, fq); S.done(cur); }
        if (!has_next) break;
#pragma unroll
        for (int a = 0; a < 2; ++a)
#pragma unroll
            for (int b = 0; b < 2; ++b)
#pragma unroll
                for (int m = 0; m < 4; ++m)
#pragma unroll
                    for (int n = 0; n < 2; ++n) acc[a][b][m][n] = (f32x4){0.f, 0.f, 0.f, 0.f};
        cur = nxt; cA = nA; cB = nB; ++ui;
        if constexpr (ALIGN_EPI) { if (wr == 1) PG8_BAR; }
    }
    PG8_WAIT_V(0);
    if constexpr (!ALIGN_EPI) { if (wr == 0) PG8_BAR; }
    PG8_BAR;
    if constexpr (Epi::AFTER_DRAIN) { E.fused(acc, cur, wr, wc, fr, fq, lds, wid, lane); S.done(cur); }
#undef PG8_SA
#undef PG8_SB
#undef PG8_STAGE
#undef PG8_LDA
#undef PG8_LDB
#undef PG8_MMA
#undef PG8_WAIT_V
#undef PG8_WAIT_L
#undef PG8_BAR
#undef PG8_SCHED
}
}

#define GAS __attribute__((address_space(1)))
#define LAS __attribute__((address_space(3)))
typedef unsigned short bf16;
typedef float f32x4 __attribute__((ext_vector_type(4)));
typedef float f32x2 __attribute__((ext_vector_type(2)));
typedef float f32x16 __attribute__((ext_vector_type(16)));
typedef short bf16x8 __attribute__((ext_vector_type(8)));
typedef unsigned u32x4 __attribute__((ext_vector_type(4)));
typedef unsigned u32x2 __attribute__((ext_vector_type(2)));
typedef __bf16 bf16x2_t __attribute__((ext_vector_type(2)));

constexpr int NWAVES = 8, NTHR = 512;
constexpr int NB = 8, SEQ = 2048, DM = 1024, MTOK = NB * SEQ;
constexpr int EIN_SRC = 3104, EIN_N = 3072, FF = 2816, FGU_N = 2 * FF, OIN_SRC = 416, OIN_N = 512, UQ_N = 1536, UKV_N = 2048, NEXP = 8;
constexpr int MAXT = 136, HALFT = 72;
constexpr float ALPHA = 1.4142135623730951f;
constexpr float LOG2E = 1.4426950408889634f;
constexpr float LAM_INIT = 0.2f;

constexpr size_t MiB = 1u << 20;
constexpr size_t WS_CTL = 0, CTL_ZERO_BYTES = 1 * MiB;
constexpr size_t WS_W_EIN = 1 * MiB, WS_W_EOUT = 8 * MiB, WS_W_FGU = 10 * MiB, WS_W_FDN = 21 * MiB, WS_W_OIN = 27 * MiB, WS_W_UQ = 28 * MiB, WS_W_UKV = 29 * MiB,
                 WS_W_OOUT = 30 * MiB, WS_W_MGU = 32 * MiB, WS_W_MDN = 120 * MiB;
constexpr size_t WS_TAB = 164 * MiB;
constexpr size_t WS_ROPE = WS_TAB, WS_LUT = WS_TAB + 256 * 1024, WS_TOKE = WS_TAB + 512 * 1024, WS_TOKW = WS_TAB + 640 * 1024, WS_POS = WS_TAB + 768 * 1024,
                 WS_BLKCNT = WS_TAB + 896 * 1024, WS_TILEE = WS_TAB + 960 * 1024;
constexpr size_t WS_XB = 166 * MiB;
constexpr size_t WS_QG = 198 * MiB, WS_KG = 206 * MiB, WS_VG = 214 * MiB, WS_GG = 230 * MiB, WS_QD = 246 * MiB, WS_KD = 262 * MiB, WS_VDT = 278 * MiB, WS_ALR = 294 * MiB,
                 WS_OB = 296 * MiB, WS_AO = 328 * MiB, WS_OF = WS_XB;
constexpr size_t WS_H = 198 * MiB;
constexpr size_t WS_CQ = 198 * MiB, WS_CKV = 214 * MiB, WS_KR = 222 * MiB, WS_CQN = 224 * MiB, WS_CKVN = 232 * MiB, WS_Q = 236 * MiB, WS_K = 284 * MiB, WS_VT = 332 * MiB, WS_AO2 = 198 * MiB;
constexpr size_t WS_XP = 198 * MiB, WS_HP = 266 * MiB;
constexpr size_t WS_END = 366 * MiB;
static_assert(WS_HP + (size_t)HALFT * 256 * FF * 2 <= WS_END && WS_XP + (size_t)MAXT * 256 * DM * 2 <= WS_HP, "moe map");
constexpr int CW_BAR = 4096;
constexpr int RING_BYTES = 131072, LDSCTL_OFF = RING_BYTES, MISC_OFF = LDSCTL_OFF + 320, LDS_BYTES = 147456;

#define RLX_AGENT __ATOMIC_RELAXED, __HIP_MEMORY_SCOPE_AGENT
#define LDS_WAIT() asm volatile("s_waitcnt lgkmcnt(0)" ::: "memory")
__device__ __forceinline__ unsigned f2bf(float f) { unsigned u = __builtin_bit_cast(unsigned, f); return (u + 0x7fffu + ((u >> 16) & 1u)) >> 16; }
__device__ __forceinline__ unsigned pk2(float lo, float hi) { return f2bf(lo) | (f2bf(hi) << 16); }
__device__ __forceinline__ float bf2f(unsigned short b) { return __builtin_bit_cast(float, (unsigned)b << 16); }
__device__ __forceinline__ unsigned cvtpk(float lo, float hi) { f32x2 v = {lo, hi}; bf16x2_t b = __builtin_convertvector(v, bf16x2_t); return __builtin_bit_cast(unsigned, b); }
__device__ __forceinline__ float wave_sum(float v) {
#pragma unroll
    for (int o = 1; o < 64; o <<= 1) v += __shfl_xor(v, o);
    return v;
}

#define XB_TMO      128
#define XB_XCNT(j)  (256  + 64 * (j))
#define XB_XSUB(j)  (1280 + 64 * (j))
#define XB_XGEN(j)  (2304 + 64 * (j))
#define XB_TOP      3328
#define XB_TOPGEN   3392
#define XCD_BAR_WORDS 3456
#define XB_SPIN_CAP (1u << 18)
__device__ __forceinline__ unsigned xb_ld(unsigned* p)              { return __hip_atomic_load(p, __ATOMIC_RELAXED, __HIP_MEMORY_SCOPE_AGENT); }
__device__ __forceinline__ unsigned xb_add(unsigned* p, unsigned v) { return __hip_atomic_fetch_add(p, v, __ATOMIC_RELAXED, __HIP_MEMORY_SCOPE_AGENT); }
__device__ __forceinline__ unsigned xb_xcc_id() { return (unsigned)__builtin_amdgcn_s_getreg((3 << 11) | 20) & 0xFu; }
#define XB_SPIN(cond, bar) do { unsigned _sp = 0; while (cond) { __builtin_amdgcn_s_sleep(1); \
    if ((++_sp & 255u) == 0u) { if (xb_ld(&(bar)[XB_TMO])) break; if (_sp > XB_SPIN_CAP) { atomicAdd(&(bar)[XB_TMO], 1u); break; } } } } while (0)
struct XcdBarrier { unsigned* bar; unsigned x; volatile LAS unsigned* st; };
__device__ __forceinline__ XcdBarrier xcd_barrier_post(unsigned* bar, volatile LAS unsigned* st) {
    XcdBarrier b; b.bar = bar; b.x = xb_xcc_id(); b.st = st;
    if (threadIdx.x == 0) (void)xb_add(&bar[XB_XCNT(b.x)], 1u);
    return b;
}
__device__ __forceinline__ void xcd_barrier_complete(unsigned* bar, unsigned x, unsigned& nloc, unsigned& nx) {
    const unsigned G = gridDim.x * gridDim.y * gridDim.z;
    unsigned sum, cnt, mine, sp = 0u;
    for (;;) {
        sum = 0u; cnt = 0u; mine = 0u;
#pragma unroll
        for (unsigned j = 0; j < 16; ++j) { const unsigned c = xb_ld(&bar[XB_XCNT(j)]); sum += c; cnt += (c > 0u) ? 1u : 0u; mine = (j == x) ? c : mine; }
        if (sum == G) break;
        __builtin_amdgcn_s_sleep(1);
        if ((++sp & 255u) == 0u) { if (xb_ld(&bar[XB_TMO])) break; if (sp > XB_SPIN_CAP) { atomicAdd(&bar[XB_TMO], 1u); break; } }
    }
    nloc = mine > 0u ? mine : 1u; nx = cnt > 0u ? cnt : 1u;
}
__device__ __forceinline__ void xcd_barrier(const XcdBarrier& b) {
    asm volatile("s_waitcnt vmcnt(0)" ::: "memory");
    __syncthreads();
    if (threadIdx.x == 0) {
        unsigned* bar = b.bar;
        __builtin_amdgcn_s_waitcnt(0);
        unsigned nloc = b.st[0], nx = b.st[1];
        if (nloc == 0u) { xcd_barrier_complete(bar, b.x, nloc, nx); b.st[0] = nloc; b.st[1] = nx; }
        const unsigned old = xb_add(&bar[XB_XSUB(b.x)], 1u);
        const unsigned gen = old / nloc;
        if (old + 1u == (gen + 1u) * nloc) {
            __builtin_amdgcn_fence(__ATOMIC_RELEASE, "agent");
            asm volatile("s_waitcnt vmcnt(0)" ::: "memory");
            const unsigned og = xb_add(&bar[XB_TOP], 1u);
            const unsigned tg = og / nx;
            if (og + 1u == (tg + 1u) * nx) xb_add(&bar[XB_TOPGEN], 1u);
            else XB_SPIN(xb_ld(&bar[XB_TOPGEN]) == tg, bar);
            __builtin_amdgcn_fence(__ATOMIC_ACQUIRE, "agent");
            xb_add(&bar[XB_XGEN(b.x)], 1u);
            asm volatile("s_waitcnt vmcnt(0)" ::: "memory");
        } else {
            XB_SPIN(xb_ld(&bar[XB_XGEN(b.x)]) == gen, bar);
            __builtin_amdgcn_fence(__ATOMIC_ACQUIRE, "agent");
            asm volatile("s_waitcnt vmcnt(0)" ::: "memory");
        }
    }
    __syncthreads();
}

__device__ __forceinline__ void tr_item(const float* W, int K, int N, bf16* WT, int dstrow0, LAS float* scr, int kb, int n0, int lane) {
    const int k0 = 64 * kb;
#pragma unroll 8
    for (int i = 0; i < 32; ++i) { const int kk = 2 * i + (lane >> 5); scr[kk * 33 + (lane & 31)] = W[(size_t)(k0 + kk) * N + n0 + (lane & 31)]; }
    LDS_WAIT(); asm volatile("" ::: "memory");
    const int c = lane & 7;
#pragma unroll
    for (int j = 0; j < 4; ++j) { const int n = (lane >> 3) + 8 * j; const LAS float* s = scr + (8 * c) * 33 + n;
        u32x4 o; o.x = pk2(s[0 * 33], s[1 * 33]); o.y = pk2(s[2 * 33], s[3 * 33]); o.z = pk2(s[4 * 33], s[5 * 33]); o.w = pk2(s[6 * 33], s[7 * 33]);
        *(GAS u32x4*)(WT + (size_t)(dstrow0 + n) * K + k0 + 8 * c) = o; }
    LDS_WAIT(); asm volatile("" ::: "memory");
}
template <int MODE>
__device__ __forceinline__ void tr_matrix(const float* W, int K, int N, bf16* WT, int row_off, LAS float* scr, int gw, int NGW, int lane) {
    const int nblk = N / 32, nitems = (K / 64) * nblk;
    for (int it = gw; it < nitems; it += NGW) { const int kb = it / nblk, n0 = 32 * (it % nblk); int d;
        if (MODE == 0) d = n0;
        else if (MODE == 1) { if (n0 == 1536) continue; d = (n0 < 1536) ? n0 : n0 - 32; }
        else d = 256 * (n0 >> 7) + (n0 & 127) + (MODE == 3 ? 128 : 0);
        tr_item(W, K, N, WT, row_off + d, scr, kb, n0, lane); }
}
__device__ __forceinline__ void row_to_bf16(const float* xrow, bf16* orow, int lane) {
    const GAS f32x4* xr = (const GAS f32x4*)xrow + lane; GAS unsigned long long* o8 = (GAS unsigned long long*)orow + lane;
#pragma unroll
    for (int j = 0; j < 4; ++j) { const f32x4 v = xr[64 * j]; o8[64 * j] = (unsigned long long)pk2(v.x, v.y) | ((unsigned long long)pk2(v.z, v.w) << 32); }
}
__device__ __forceinline__ void ln_apply(f32x4 (&v)[4], const float* g, const float* b, int lane) {
    float s = 0.f;
#pragma unroll
    for (int j = 0; j < 4; ++j) s += (v[j].x + v[j].y) + (v[j].z + v[j].w);
    const float mean = wave_sum(s) * (1.f / DM); float s2 = 0.f;
#pragma unroll
    for (int j = 0; j < 4; ++j) { v[j] = v[j] - mean; s2 += (v[j].x * v[j].x + v[j].y * v[j].y) + (v[j].z * v[j].z + v[j].w * v[j].w); }
    const float rstd = 1.f / sqrtf(wave_sum(s2) * (1.f / DM) + 1e-5f);
#pragma unroll
    for (int j = 0; j < 4; ++j) { const f32x4 gg = *((const f32x4*)g + lane + 64 * j), bb = *((const f32x4*)b + lane + 64 * j); v[j] = v[j] * rstd * gg + bb; }
}
__device__ __forceinline__ void store_row_f32_bf16(const f32x4 (&v)[4], float* frow, bf16* brow, int lane) {
    GAS f32x4* fr = (GAS f32x4*)frow + lane; GAS unsigned long long* o8 = (GAS unsigned long long*)brow + lane;
#pragma unroll
    for (int j = 0; j < 4; ++j) { fr[64 * j] = v[j]; o8[64 * j] = (unsigned long long)pk2(v[j].x, v[j].y) | ((unsigned long long)pk2(v[j].z, v[j].w) << 32); }
}

struct AttnP {
    const bf16* Q; const bf16* K; const bf16* VT; bf16* O;
    const float* lut;
    const float* dlam;
    const float* dgain;
};
template <bool DIFF>
__device__ __forceinline__ void attn_phase(LAS unsigned char* lds, const AttnP& P, int G, int c, unsigned* qctr) {
    constexpr int KW = DIFF ? 128 : 96, DQ = DIFF ? 64 : 96, DV = DIFF ? 128 : 64, NH = DIFF ? 4 : 16;
    constexpr int LDQ = DIFF ? 512 : 1536, LDK = DIFF ? 512 : 1536, HQ = DIFF ? 128 : 96;
    constexpr int KPITCH = KW * 2 + 16, VPITCH = 144, KBYTES = 64 * KPITCH, VBYTES = DV * VPITCH, STAGE = KBYTES + VBYTES;
    constexpr int NDS = DQ / 16, NRB = DV / 32, KPR = KW / 8, NKPIECE = 64 * KPR, NVPIECE = DV * 8;
    constexpr int NKI = (NKPIECE + NTHR - 1) / NTHR, NVI = (NVPIECE + NTHR - 1) / NTHR;
    constexpr int QROWS = DIFF ? 128 : 256, NQB = SEQ / QROWS, NUNITS = NB * NH * NQB;
    constexpr int LUT_OFF = 2 * STAGE;
    static_assert(LUT_OFF + (DIFF ? 8192 : 0) <= RING_BYTES && 2 * STAGE >= (DIFF ? 65536 : 0), "attn lds");
    const int tid = threadIdx.x, lane = tid & 63, wid = __builtin_amdgcn_readfirstlane(tid >> 6), r = lane & 31, h2 = lane >> 5;
    const int pir = (r & ~12) | ((r & 4) << 1) | ((r & 8) >> 1);
    float lam = 0.f;
    if (DIFF) {
        LAS float* L = (LAS float*)(lds + LUT_OFF);
        for (int i = tid; i < 4 * 512; i += NTHR) L[i] = P.lut[i];
        const float a = P.dlam[lane] * P.dlam[64 + lane], b2 = P.dlam[128 + lane] * P.dlam[192 + lane];
        lam = __expf(wave_sum(a)) - __expf(wave_sum(b2)) + LAM_INIT;
        __syncthreads();
    }
    for (int it = 0;; ++it) {
        int unit;
        if (qctr) {
            __syncthreads();
            if (tid == 0) *(volatile LAS int*)(lds + RING_BYTES - 16) = (int)__hip_atomic_fetch_add(qctr, 1u, __ATOMIC_RELAXED, __HIP_MEMORY_SCOPE_AGENT);
            __syncthreads();
            unit = *(volatile LAS int*)(lds + RING_BYTES - 16);
        } else unit = c + it * G;
        if (unit >= NUNITS) break;
        int b, h, q0, map;
        if (DIFF) { const int qb = unit & 15; h = (unit >> 4) & 3; b = unit >> 6; map = wid >> 2; q0 = qb * 128 + 32 * (wid & 3); }
        else { const int qb = unit & 7; h = (unit >> 3) & 15; b = unit >> 7; map = 0; q0 = qb * 256 + 32 * wid; }
        const size_t tok0 = (size_t)b * SEQ;
        bf16x8 qf[NDS];
        { const bf16* qp = P.Q + (tok0 + q0 + r) * LDQ + h * HQ + map * 64 + 8 * h2;
#pragma unroll
          for (int ds = 0; ds < NDS; ++ds) qf[ds] = *(const bf16x8*)(qp + 16 * ds); }
        const bf16* Kb = P.K + tok0 * LDK + h * HQ;
        const bf16* Vb = P.VT + (size_t)(b * NH + h) * DV * SEQ;
        u32x4 kst[NKI], vst[NVI];
#define ATT_LOAD(t) do { \
        _Pragma("unroll") for (int i = 0; i < NKI; ++i) { const int p = tid + i * NTHR; if (NKPIECE % NTHR == 0 || p < NKPIECE) { const int row = p / KPR, cp = p % KPR; kst[i] = *(const u32x4*)(Kb + (size_t)(64 * (t) + row) * LDK + 8 * cp); } } \
        _Pragma("unroll") for (int i = 0; i < NVI; ++i) { const int p = tid + i * NTHR; const int row = p >> 3, cp = p & 7; vst[i] = *(const u32x4*)(Vb + (size_t)row * SEQ + 64 * (t) + 8 * cp); } } while (0)
#define ATT_STORE(buf) do { \
        _Pragma("unroll") for (int i = 0; i < NKI; ++i) { const int p = tid + i * NTHR; if (NKPIECE % NTHR == 0 || p < NKPIECE) { const int row = p / KPR, cp = p % KPR; *(LAS u32x4*)(lds + (buf) * STAGE + row * KPITCH + 16 * cp) = kst[i]; } } \
        _Pragma("unroll") for (int i = 0; i < NVI; ++i) { const int p = tid + i * NTHR; const int row = p >> 3, cp = p & 7; *(LAS u32x4*)(lds + (buf) * STAGE + KBYTES + row * VPITCH + 16 * cp) = vst[i]; } } while (0)
        f32x16 O[NRB];
#pragma unroll
        for (int rb = 0; rb < NRB; ++rb)
#pragma unroll
            for (int i = 0; i < 16; ++i) O[rb][i] = 0.f;
        float mrun = -1e30f, lrun = 0.f;
        ATT_LOAD(0); ATT_STORE(0); __syncthreads();
        const int koff = pir * KPITCH + (map * 64 + 8 * h2) * 2, voff = KBYTES + r * VPITCH + 16 * h2;
        const int qpos = q0 + r, qlo = q0, qhi = q0 + 31;
        for (int t = 0; t < SEQ / 64; ++t) {
            const int buf = t & 1;
            if (t + 1 < SEQ / 64) ATT_LOAD(t + 1);
            const LAS unsigned char* kb = lds + buf * STAGE + koff; const LAS unsigned char* vb = lds + buf * STAGE + voff;
            f32x16 st[2];
#pragma unroll
            for (int kg = 0; kg < 2; ++kg) {
#pragma unroll
                for (int i = 0; i < 16; ++i) st[kg][i] = 0.f;
#pragma unroll
                for (int ds = 0; ds < NDS; ++ds) { const bf16x8 kf = *(const LAS bf16x8*)(kb + kg * 32 * KPITCH + ds * 32); st[kg] = __builtin_amdgcn_mfma_f32_32x32x16_bf16(kf, qf[ds], st[kg], 0, 0, 0); }
            }
            if (DIFF) {
                const LAS float* L = (const LAS float*)(lds + LUT_OFF) + h * 512;
                const int k0 = 64 * t;
                if (k0 - qhi >= 91) { const float cb = L[256 + 100];
#pragma unroll
                    for (int kg = 0; kg < 2; ++kg)
#pragma unroll
                        for (int i = 0; i < 16; ++i) st[kg][i] += cb;
                } else if (qlo - (k0 + 63) >= 91) { const float cb = L[256 - 100];
#pragma unroll
                    for (int kg = 0; kg < 2; ++kg)
#pragma unroll
                        for (int i = 0; i < 16; ++i) st[kg][i] += cb;
                } else {
                    const int base = k0 + 8 * h2 - qpos + 256;
#pragma unroll
                    for (int kg = 0; kg < 2; ++kg)
#pragma unroll
                        for (int i = 0; i < 16; ++i) st[kg][i] += L[base + 32 * kg + 16 * (i >> 3) + (i & 7)];
                }
            }
            float mx = st[0][0];
#pragma unroll
            for (int i = 1; i < 16; ++i) mx = fmaxf(mx, st[0][i]);
#pragma unroll
            for (int i = 0; i < 16; ++i) mx = fmaxf(mx, st[1][i]);
            mx = fmaxf(mx, __shfl_xor(mx, 32));
            const float mnew = fmaxf(mrun, mx); const float alpha = __builtin_amdgcn_exp2f(mrun - mnew); mrun = mnew;
            float rs = 0.f;
#pragma unroll
            for (int kg = 0; kg < 2; ++kg)
#pragma unroll
                for (int i = 0; i < 16; ++i) { const float p = __builtin_amdgcn_exp2f(st[kg][i] - mnew); st[kg][i] = p; rs += p; }
            lrun = lrun * alpha + rs;
#pragma unroll
            for (int rb = 0; rb < NRB; ++rb)
#pragma unroll
                for (int i = 0; i < 16; ++i) O[rb][i] *= alpha;
            bf16x8 pf[2][2];
#pragma unroll
            for (int kg = 0; kg < 2; ++kg)
#pragma unroll
                for (int s2 = 0; s2 < 2; ++s2) { u32x4 w; w.x = cvtpk(st[kg][8 * s2 + 0], st[kg][8 * s2 + 1]); w.y = cvtpk(st[kg][8 * s2 + 2], st[kg][8 * s2 + 3]);
                    w.z = cvtpk(st[kg][8 * s2 + 4], st[kg][8 * s2 + 5]); w.w = cvtpk(st[kg][8 * s2 + 6], st[kg][8 * s2 + 7]); pf[kg][s2] = __builtin_bit_cast(bf16x8, w); }
#pragma unroll
            for (int rb = 0; rb < NRB; ++rb) {
#pragma unroll
                for (int kg = 0; kg < 2; ++kg)
#pragma unroll
                    for (int s2 = 0; s2 < 2; ++s2) { const bf16x8 vf = *(const LAS bf16x8*)(vb + rb * 32 * VPITCH + (32 * kg + 16 * s2) * 2); O[rb] = __builtin_amdgcn_mfma_f32_32x32x16_bf16(vf, pf[kg][s2], O[rb], 0, 0, 0); }
                __builtin_amdgcn_sched_barrier(0); }
            if (t + 1 < SEQ / 64) ATT_STORE(buf ^ 1);
            __syncthreads();
        }
        const float ltot = lrun + __shfl_xor(lrun, 32); const float inv = 1.0f / ltot;
        int lane_e = lane; asm volatile("" : "+v"(lane_e));
        const int r_e = lane_e & 31, h2_e = lane_e >> 5;
        if (!DIFF) {
            bf16* op = P.O + (tok0 + q0 + r_e) * DM + h * 64 + 4 * h2_e;
#pragma unroll
            for (int rb = 0; rb < NRB; ++rb)
#pragma unroll
                for (int g = 0; g < 4; ++g) { u32x2 w; w.x = cvtpk(O[rb][4 * g] * inv, O[rb][4 * g + 1] * inv); w.y = cvtpk(O[rb][4 * g + 2] * inv, O[rb][4 * g + 3] * inv); *(u32x2*)(op + 32 * rb + 8 * g) = w; }
        } else {
            LAS float* X = (LAS float*)lds;
            if (map == 1) { const float sc = inv * lam;
#pragma unroll
                for (int rb = 0; rb < NRB; ++rb)
#pragma unroll
                    for (int i = 0; i < 16; ++i) X[((wid - 4) * 64 + rb * 16 + i) * 64 + lane_e] = O[rb][i] * sc; }
            __syncthreads();
            if (map == 0) { float ss = 0.f;
#pragma unroll
                for (int rb = 0; rb < NRB; ++rb)
#pragma unroll
                    for (int i = 0; i < 16; ++i) { const float o = O[rb][i] * inv - X[(wid * 64 + rb * 16 + i) * 64 + lane_e]; O[rb][i] = o; ss += o * o; }
                ss += __shfl_xor(ss, 32);
                const float rn = (1.0f - LAM_INIT) / sqrtf(ss * (1.0f / 128.0f) + 1e-6f);
                bf16* op = P.O + (tok0 + q0 + r_e) * DM + 512 + h * 128 + 4 * h2_e;
#pragma unroll
                for (int rb = 0; rb < NRB; ++rb)
#pragma unroll
                    for (int g = 0; g < 4; ++g) { const f32x4 gn = *(const f32x4*)(P.dgain + 32 * rb + 8 * g + 4 * h2_e);
                        u32x2 w; w.x = cvtpk(O[rb][4 * g] * rn * gn[0], O[rb][4 * g + 1] * rn * gn[1]); w.y = cvtpk(O[rb][4 * g + 2] * rn * gn[2], O[rb][4 * g + 3] * rn * gn[3]); *(u32x2*)(op + 32 * rb + 8 * g) = w; }
            }
            __syncthreads();
        }
#undef ATT_LOAD
#undef ATT_STORE
    }
}

struct GlaP { const bf16 *QG, *KG, *VGT; const float* ALR; const float* gate_up; const float* gate_bias; float* OF; float* OB; };
__device__ __forceinline__ void gla_unit(LAS unsigned char* lds, const GlaP& P, int unit) {
    constexpr int PITCH = 144, QD_OFF = 0, KN_OFF = 64 * PITCH, KE_OFF = 2 * 64 * PITCH, VT_OFF = 3 * 64 * PITCH, DC_OFF = VT_OFF + 128 * PITCH, BUF = DC_OFF + 256;
    constexpr int SG_OFF = 2 * BUF, AL_OFF = SG_OFF + 2 * 8 * 64 * 4, GLA_END = AL_OFF + 2 * 64 * 16 * 4;
    static_assert(GLA_END <= RING_BYTES, "gla lds");
    const int tid = threadIdx.x, lane = tid & 63, wid = __builtin_amdgcn_readfirstlane(tid >> 6), r = lane & 31, h2 = lane >> 5;
    const int tb = wid >> 2, db = wid & 3;
    const int b = unit >> 3, h = (unit >> 1) & 3, dir = unit & 1;
    const int pl = (lane & ~12) | ((lane & 4) << 1) | ((lane & 8) >> 1), pir = (r & ~12) | ((r & 4) << 1) | ((r & 8) >> 1);
    const size_t tok0 = (size_t)b * SEQ;
    float GU[16];
#pragma unroll
    for (int rr = 0; rr < 16; ++rr) GU[rr] = P.gate_up[(size_t)(dir * 16 + rr) * 256 + h * 64 + lane];
    const float gb = P.gate_bias[dir * 256 + h * 64 + lane];
    float* OUT = dir ? P.OB : P.OF;
    f32x16 S0, S1;
#pragma unroll
    for (int i = 0; i < 16; ++i) { S0[i] = 0.f; S1[i] = 0.f; }
    unsigned short qraw[8], kraw[8]; u32x4 vraw[2]; f32x2 alr;
#define GLA_TBASE(c) (tok0 + (size_t)64 * (dir ? (SEQ / 64 - 1 - (c)) : (c)))
#define GLA_LOAD_QKV(c) do { const size_t tbs_ = GLA_TBASE(c); \
        _Pragma("unroll") for (int tt = 0; tt < 8; ++tt) { const size_t o_ = (tbs_ + 8 * wid + tt) * 256 + h * 64 + lane; qraw[tt] = P.QG[o_]; kraw[tt] = P.KG[o_]; } \
        _Pragma("unroll") for (int i = 0; i < 2; ++i) { const int p_ = tid + i * NTHR; vraw[i] = *(const u32x4*)(P.VGT + ((size_t)(b * 4 + h) * 128 + (p_ >> 3)) * SEQ + (tbs_ - tok0) + 8 * (p_ & 7)); } } while (0)
#define GLA_LOAD_AL(c) do { alr = *(const f32x2*)(P.ALR + (GLA_TBASE(c) + (tid >> 3)) * 32 + dir * 16 + 2 * (tid & 7)); } while (0)
    __syncthreads();
    GLA_LOAD_AL(0); GLA_LOAD_QKV(0);
    *(LAS f32x2*)(lds + AL_OFF + tid * 8) = alr;
    __syncthreads();
    for (int c = 0; c < SEQ / 64; ++c) {
        const int buf = c & 1; LAS unsigned char* B = lds + buf * BUF;
        if (c + 1 < SEQ / 64) GLA_LOAD_AL(c + 1);
        float p[8]; float segtot;
        { const LAS f32x4* al4 = (const LAS f32x4*)(lds + AL_OFF + buf * 4096) + (8 * wid) * 4; float la[8];
#pragma unroll
          for (int tt = 0; tt < 8; ++tt) { float x = gb;
#pragma unroll
              for (int q4 = 0; q4 < 4; ++q4) { const f32x4 a = al4[tt * 4 + q4]; x += a[0] * GU[4 * q4] + a[1] * GU[4 * q4 + 1] + a[2] * GU[4 * q4 + 2] + a[3] * GU[4 * q4 + 3]; }
              la[tt] = (fminf(x, 0.f) - log1pf(__expf(-fabsf(x)))) * (1.0f / 16.0f); }
          if (!dir) { float a = 0.f;
#pragma unroll
              for (int tt = 0; tt < 8; ++tt) { a += la[tt]; p[tt] = a; } segtot = a; }
          else { float a = 0.f;
#pragma unroll
              for (int tt = 7; tt >= 0; --tt) { a += la[tt]; p[tt] = a; } segtot = a; } }
        ((LAS float*)(lds + SG_OFF + buf * 2048))[wid * 64 + lane] = segtot;
        __syncthreads();
        { const LAS float* sg = (const LAS float*)(lds + SG_OFF + buf * 2048) + lane; float tot = 0.f, off = 0.f;
#pragma unroll
          for (int w = 0; w < 8; ++w) { const float v = sg[w * 64]; tot += v; if (dir ? (w > wid) : (w < wid)) off += v; }
          float ke[8];
#pragma unroll
          for (int tt = 0; tt < 8; ++tt) { const float bt = off + p[tt]; const float e1 = __expf(bt), e2 = __expf(-bt), e3 = __expf(tot - bt);
              const float qv = bf2f(qraw[tt]), kv = bf2f(kraw[tt]); const int t = 8 * wid + tt;
              *(LAS unsigned short*)(B + QD_OFF + t * PITCH + 2 * pl) = (unsigned short)f2bf(qv * e1);
              *(LAS unsigned short*)(B + KN_OFF + t * PITCH + 2 * pl) = (unsigned short)f2bf(kv * e2);
              ke[tt] = kv * e3; }
          u32x4 w; w.x = pk2(ke[0], ke[1]); w.y = pk2(ke[2], ke[3]); w.z = pk2(ke[4], ke[5]); w.w = pk2(ke[6], ke[7]);
          *(LAS u32x4*)(B + KE_OFF + lane * PITCH + 16 * wid) = w;
          if (wid == 0) ((LAS float*)(B + DC_OFF))[lane] = __expf(tot);
#pragma unroll
          for (int i = 0; i < 2; ++i) { const int p_ = tid + i * NTHR; *(LAS u32x4*)(B + VT_OFF + (p_ >> 3) * PITCH + 16 * (p_ & 7)) = vraw[i]; }
          if (c + 1 < SEQ / 64) { *(LAS f32x2*)(lds + AL_OFF + (buf ^ 1) * 4096 + tid * 8) = alr; GLA_LOAD_QKV(c + 1); } }
        __syncthreads();
        f32x16 O;
#pragma unroll
        for (int i = 0; i < 16; ++i) O[i] = 0.f;
        const LAS unsigned char* qd_row = B + QD_OFF + (32 * tb + r) * PITCH + 16 * h2;
        const LAS unsigned char* vt_row = B + VT_OFF + (32 * db + r) * PITCH + 16 * h2;
#pragma unroll
        for (int jt = 0; jt < 2; ++jt) {
            const bool full = dir ? (jt > tb) : (jt < tb), diag = (jt == tb);
            if (full || diag) {
                f32x16 st;
#pragma unroll
                for (int i = 0; i < 16; ++i) st[i] = 0.f;
#pragma unroll
                for (int ks = 0; ks < 4; ++ks) { const bf16x8 kf = *(const LAS bf16x8*)(B + KN_OFF + (32 * jt + pir) * PITCH + 16 * h2 + 32 * ks); const bf16x8 qf = *(const LAS bf16x8*)(qd_row + 32 * ks);
                    st = __builtin_amdgcn_mfma_f32_32x32x16_bf16(kf, qf, st, 0, 0, 0); }
                if (diag) {
#pragma unroll
                    for (int i = 0; i < 16; ++i) { const int jl = 16 * (i >> 3) + 8 * h2 + (i & 7); const bool keep = dir ? (jl >= r) : (jl <= r); st[i] = keep ? st[i] : 0.f; } }
#pragma unroll
                for (int s2 = 0; s2 < 2; ++s2) { u32x4 w; w.x = cvtpk(st[8 * s2 + 0], st[8 * s2 + 1]); w.y = cvtpk(st[8 * s2 + 2], st[8 * s2 + 3]); w.z = cvtpk(st[8 * s2 + 4], st[8 * s2 + 5]); w.w = cvtpk(st[8 * s2 + 6], st[8 * s2 + 7]);
                    const bf16x8 vf = *(const LAS bf16x8*)(vt_row + (32 * jt + 16 * s2) * 2);
                    O = __builtin_amdgcn_mfma_f32_32x32x16_bf16(vf, __builtin_bit_cast(bf16x8, w), O, 0, 0, 0); }
            }
        }
#pragma unroll
        for (int s = 0; s < 2; ++s) { u32x4 w0, w1;
            w0.x = cvtpk(S0[8 * s + 0], S0[8 * s + 1]); w0.y = cvtpk(S0[8 * s + 2], S0[8 * s + 3]); w0.z = cvtpk(S0[8 * s + 4], S0[8 * s + 5]); w0.w = cvtpk(S0[8 * s + 6], S0[8 * s + 7]);
            w1.x = cvtpk(S1[8 * s + 0], S1[8 * s + 1]); w1.y = cvtpk(S1[8 * s + 2], S1[8 * s + 3]); w1.z = cvtpk(S1[8 * s + 4], S1[8 * s + 5]); w1.w = cvtpk(S1[8 * s + 6], S1[8 * s + 7]);
            const bf16x8 q0 = *(const LAS bf16x8*)(qd_row + (16 * s) * 2), q1 = *(const LAS bf16x8*)(qd_row + (32 + 16 * s) * 2);
            O = __builtin_amdgcn_mfma_f32_32x32x16_bf16(__builtin_bit_cast(bf16x8, w0), q0, O, 0, 0, 0);
            O = __builtin_amdgcn_mfma_f32_32x32x16_bf16(__builtin_bit_cast(bf16x8, w1), q1, O, 0, 0, 0); }
        { const LAS f32x4* dc = (const LAS f32x4*)(B + DC_OFF) + h2;
#pragma unroll
          for (int g = 0; g < 4; ++g) { const f32x4 d0 = dc[2 * g], d1 = dc[8 + 2 * g];
#pragma unroll
              for (int e = 0; e < 4; ++e) { S0[4 * g + e] *= d0[e]; S1[4 * g + e] *= d1[e]; } }
#pragma unroll
          for (int ks = 0; ks < 4; ++ks) { const bf16x8 vf = *(const LAS bf16x8*)(vt_row + 32 * ks);
              const bf16x8 k0 = *(const LAS bf16x8*)(B + KE_OFF + r * PITCH + 16 * h2 + 32 * ks), k1 = *(const LAS bf16x8*)(B + KE_OFF + (32 + r) * PITCH + 16 * h2 + 32 * ks);
              S0 = __builtin_amdgcn_mfma_f32_32x32x16_bf16(k0, vf, S0, 0, 0, 0); S1 = __builtin_amdgcn_mfma_f32_32x32x16_bf16(k1, vf, S1, 0, 0, 0); } }
        { float* op = OUT + (GLA_TBASE(c) + 32 * tb + r) * 512 + h * 128 + 32 * db + 4 * h2;
#pragma unroll
          for (int g = 0; g < 4; ++g) *(f32x4*)(op + 8 * g) = (f32x4){O[4 * g], O[4 * g + 1], O[4 * g + 2], O[4 * g + 3]}; }
    }
    __syncthreads();
#undef GLA_TBASE
#undef GLA_LOAD_QKV
#undef GLA_LOAD_AL
}

#ifndef MK_PER_PHASE
#define MK_PER_PHASE 0
#endif
constexpr int NPHASE = 21;
struct Args { const float* in[24]; float* out; unsigned char* ws; int ph_lo, ph_hi, flags, pad; };
static_assert(sizeof(Args) == 24 * 8 + 8 + 8 + 16, "Args has no padding");
enum { I_X = 0, I_RELB, I_EWIN, I_GUP, I_GBIAS, I_GLAGAIN, I_DLAM, I_DGAIN, I_EWOUT, I_FG, I_FU, I_FD, I_OWIN, I_QGAIN, I_KVGAIN, I_WUQ, I_WUKV, I_OWOUT, I_ROUTER, I_MG, I_MU, I_MD, I_LNG, I_LNB };

__global__ void __launch_bounds__(NTHR, 2) mega_fwd(Args args) {
    extern __shared__ __attribute__((aligned(16))) unsigned char lds_raw[];
    LAS unsigned char* lds = (LAS unsigned char*)lds_raw;
    volatile LAS unsigned* MISC = (volatile LAS unsigned*)(lds + MISC_OFF);
    const int tid = threadIdx.x, lane = tid & 63, wave = __builtin_amdgcn_readfirstlane(tid >> 6);
    const int G = gridDim.x, bx = blockIdx.x;
    const int vcu = (G % 8 == 0) ? (bx % 8) * (G / 8) + bx / 8 : bx;
    const int gw = vcu * NWAVES + wave, NGW = G * NWAVES;
    unsigned char* ws = args.ws;
    for (int u = tid; u < (LDS_BYTES - LDSCTL_OFF) / 4; u += NTHR) ((LAS unsigned*)(lds + LDSCTL_OFF))[u] = 0u;
    __syncthreads();
    const int lo = args.ph_lo, hi = args.ph_hi;
    XcdBarrier bar; bar.bar = (unsigned*)(ws + WS_CTL) + CW_BAR; bar.x = 0; bar.st = nullptr;
    if (hi - lo > 1) bar = xcd_barrier_post((unsigned*)(ws + WS_CTL) + CW_BAR, MISC + 8);
#ifdef ONLY_PHASE
#define IN(k) ((k) == ONLY_PHASE && lo <= (k) && (k) < hi)
#else
#define IN(k) (lo <= (k) && (k) < hi)
#endif
#define SEAM(k) do { if (IN(k) && IN((k) + 1)) xcd_barrier(bar); } while (0)

    const float* x_in = args.in[I_X];
    const float* ln_g = args.in[I_LNG]; const float* ln_b = args.in[I_LNB];
    float* XF = args.out;
    bf16* W_EIN = (bf16*)(ws + WS_W_EIN); bf16* W_EOUT = (bf16*)(ws + WS_W_EOUT); bf16* W_FGU = (bf16*)(ws + WS_W_FGU); bf16* W_FDN = (bf16*)(ws + WS_W_FDN);
    bf16* W_OIN = (bf16*)(ws + WS_W_OIN); bf16* W_UQ = (bf16*)(ws + WS_W_UQ); bf16* W_UKV = (bf16*)(ws + WS_W_UKV); bf16* W_OOUT = (bf16*)(ws + WS_W_OOUT);
    bf16* W_MGU = (bf16*)(ws + WS_W_MGU); bf16* W_MDN = (bf16*)(ws + WS_W_MDN);
    float* ROPE = (float*)(ws + WS_ROPE); float* LUT = (float*)(ws + WS_LUT);
    int* TOKE = (int*)(ws + WS_TOKE); float* TOKW = (float*)(ws + WS_TOKW); int* POS = (int*)(ws + WS_POS); int* BLKCNT = (int*)(ws + WS_BLKCNT); int* TILEE = (int*)(ws + WS_TILEE);
    bf16* XB = (bf16*)(ws + WS_XB);
    bf16* QG = (bf16*)(ws + WS_QG); bf16* KG = (bf16*)(ws + WS_KG); bf16* VG = (bf16*)(ws + WS_VG); bf16* GG = (bf16*)(ws + WS_GG);
    bf16* QD = (bf16*)(ws + WS_QD); bf16* KD = (bf16*)(ws + WS_KD); bf16* VDT = (bf16*)(ws + WS_VDT); float* ALR = (float*)(ws + WS_ALR);
    float* OFb = (float*)(ws + WS_OF); float* OBb = (float*)(ws + WS_OB); bf16* AO = (bf16*)(ws + WS_AO);
    bf16* Hb = (bf16*)(ws + WS_H);
    float* CQ = (float*)(ws + WS_CQ); float* CKV = (float*)(ws + WS_CKV); float* KR = (float*)(ws + WS_KR); bf16* CQN = (bf16*)(ws + WS_CQN); bf16* CKVN = (bf16*)(ws + WS_CKVN);
    bf16* Qb = (bf16*)(ws + WS_Q); bf16* Kb = (bf16*)(ws + WS_K); bf16* VTb = (bf16*)(ws + WS_VT); bf16* AO2 = (bf16*)(ws + WS_AO2);
    bf16* XP = (bf16*)(ws + WS_XP); bf16* HP = (bf16*)(ws + WS_HP);

    if (IN(0)) {
        LAS float* scr = (LAS float*)(lds + wave * 16384);
        int off = 0;
#define TRM(MODE, W, K, N, WT, ROFF) do { const int nit_ = ((K) / 64) * ((N) / 32); int g0_ = (gw - off) % NGW; if (g0_ < 0) g0_ += NGW; tr_matrix<MODE>((W), (K), (N), (WT), (ROFF), scr, g0_, NGW, lane); off = (off + nit_) % NGW; } while (0)
        TRM(1, args.in[I_EWIN], 1024, EIN_SRC, W_EIN, 0);
        TRM(0, args.in[I_EWOUT], 1024, 1024, W_EOUT, 0);
        TRM(2, args.in[I_FG], 1024, FF, W_FGU, 0);
        TRM(3, args.in[I_FU], 1024, FF, W_FGU, 0);
        TRM(0, args.in[I_FD], FF, 1024, W_FDN, 0);
        TRM(0, args.in[I_OWIN], 1024, OIN_SRC, W_OIN, 0);
        TRM(0, args.in[I_WUQ], 256, UQ_N, W_UQ, 0);
        TRM(0, args.in[I_WUKV], 128, UKV_N, W_UKV, 0);
        TRM(0, args.in[I_OWOUT], 1024, 1024, W_OOUT, 0);
        for (int e = 0; e < NEXP; ++e) {
            TRM(2, args.in[I_MG] + (size_t)e * 1024 * FF, 1024, FF, W_MGU, e * FGU_N);
            TRM(3, args.in[I_MU] + (size_t)e * 1024 * FF, 1024, FF, W_MGU, e * FGU_N);
            TRM(0, args.in[I_MD] + (size_t)e * FF * 1024, FF, 1024, W_MDN, e * 1024);
        }
#undef TRM
        for (int m = gw; m < MTOK; m += NGW) row_to_bf16(x_in + (size_t)m * DM, XB + (size_t)m * DM, lane);
        __syncthreads();
        { constexpr int WP = 2064; const float* Wsrc = args.in[I_EWIN] + 1536;
          for (int e = tid; e < 32 * 1024; e += NTHR) { const int k = e >> 5, n = e & 31; *(LAS unsigned short*)(lds + n * WP + 2 * k) = (unsigned short)f2bf(Wsrc[(size_t)k * EIN_SRC + n]); }
          __syncthreads();
          const int r = lane & 31, h2 = lane >> 5;
          for (int task = wave * G + bx; task < MTOK / 32; task += NWAVES * G) {
              f32x16 acc;
#pragma unroll
              for (int i = 0; i < 16; ++i) acc[i] = 0.f;
              const float* xr = x_in + (size_t)(32 * task + r) * DM + 8 * h2;
#pragma unroll 4
              for (int ks = 0; ks < 64; ++ks) { const f32x4 a0 = *(const f32x4*)(xr + 16 * ks), a1 = *(const f32x4*)(xr + 16 * ks + 4);
                  u32x4 w; w.x = cvtpk(a0[0], a0[1]); w.y = cvtpk(a0[2], a0[3]); w.z = cvtpk(a1[0], a1[1]); w.w = cvtpk(a1[2], a1[3]);
                  const bf16x8 bfr = *(const LAS bf16x8*)(lds + r * WP + (16 * ks + 8 * h2) * 2);
                  acc = __builtin_amdgcn_mfma_f32_32x32x16_bf16(__builtin_bit_cast(bf16x8, w), bfr, acc, 0, 0, 0); }
#pragma unroll
              for (int i = 0; i < 16; ++i) ALR[(size_t)(32 * task + (i & 3) + 8 * (i >> 2) + 4 * h2) * 32 + r] = acc[i];
          }
        }
        const int gt = bx * NTHR + tid, NGT = G * NTHR;
        for (int i = gt; i < SEQ * 16; i += NGT) { const int pos = i >> 4, k = i & 15; const float inv = (float)pow(10000.0, -(double)k / 16.0); const float ang = (float)pos * inv;
            ROPE[2 * i] = (float)cos((double)ang); ROPE[2 * i + 1] = (float)sin((double)ang); }
        for (int i = gt; i < 4 * 512; i += NGT) { const int h = i >> 9, rel = (i & 511) - 256; const int n = rel < 0 ? -rel : rel; int bk = rel > 0 ? 16 : 0;
            int nl = n; if (n >= 8) { nl = 8 + (31 - __clz(n * n)) - 6; if (nl > 15) nl = 15; }
            bk += nl; LUT[i] = args.in[I_RELB][bk * 4 + h] * LOG2E; }
    }
    SEAM(0);
    if (IN(1)) {
        pg8::Gemm g{XB, W_EIN, MTOK, EIN_N, DM}; pg8::StaticOrder S; S.init(MTOK, EIN_N, G, bx);
        pg8::EpiEvenIn E{QG, KG, VG, GG, QD, KD, VDT};
        pg8::gemm_phase<pg8::EpiEvenIn, pg8::StaticOrder, true, true>(lds, g, S, E);
    }
    SEAM(1);
    if (IN(2)) {
        const GlaP GP{QG, KG, VG, ALR, args.in[I_GUP], args.in[I_GBIAS], OFb, OBb};
        if (!(args.flags & 1)) for (int u = bx; u < 64; u += G) gla_unit(lds, GP, u);
        __syncthreads();
        const AttnP AP{QD, KD, VDT, AO, LUT, args.in[I_DLAM], args.in[I_DGAIN]};
        if (!(args.flags & 2)) attn_phase<true>(lds, AP, G, bx, (hi - lo > 1) ? (unsigned*)(ws + WS_CTL) + 64 : nullptr);
    }
    SEAM(2);
    if (IN(3)) {
        const float* ggain = args.in[I_GLAGAIN];
        for (int m = gw; m < MTOK; m += NGW) {
            const int hh = lane >> 4, c8 = (lane & 15) * 8; const size_t o = (size_t)m * 512 + hh * 128 + c8;
            const f32x4 a0 = *(const f32x4*)(OFb + o), a1 = *(const f32x4*)(OFb + o + 4), b0 = *(const f32x4*)(OBb + o), b1 = *(const f32x4*)(OBb + o + 4);
            const f32x4 v0 = a0 + b0, v1 = a1 + b1;
            float ss = (v0.x * v0.x + v0.y * v0.y) + (v0.z * v0.z + v0.w * v0.w) + (v1.x * v1.x + v1.y * v1.y) + (v1.z * v1.z + v1.w * v1.w);
            ss += __shfl_xor(ss, 1); ss += __shfl_xor(ss, 2); ss += __shfl_xor(ss, 4); ss += __shfl_xor(ss, 8);
            const float rn = 1.0f / sqrtf(ss * (1.0f / 128.0f) + 1e-6f);
            const f32x4 g0 = *(const f32x4*)(ggain + c8), g1 = *(const f32x4*)(ggain + c8 + 4);
            const u32x4 gr = *(const u32x4*)(GG + o);
            float gt8[8];
#pragma unroll
            for (int e = 0; e < 4; ++e) { gt8[2 * e] = __builtin_bit_cast(float, gr[e] << 16); gt8[2 * e + 1] = __builtin_bit_cast(float, gr[e] & 0xffff0000u); }
            f32x4 r0, r1;
#pragma unroll
            for (int e = 0; e < 4; ++e) { r0[e] = v0[e] * rn * g0[e] * pg8::silu_f(gt8[e]); r1[e] = v1[e] * rn * g1[e] * pg8::silu_f(gt8[4 + e]); }
            u32x4 w; w.x = pk2(r0[0], r0[1]); w.y = pk2(r0[2], r0[3]); w.z = pk2(r1[0], r1[1]); w.w = pk2(r1[2], r1[3]);
            *(u32x4*)(AO + (size_t)m * DM + hh * 128 + c8) = w;
        }
    }
    SEAM(3);
    if (IN(4)) {
        pg8::Gemm g{AO, W_EOUT, MTOK, DM, DM}; pg8::StaticOrder S; S.init(MTOK, DM, G, bx);
        pg8::EpiResid E{x_in, XF, ALPHA};
        pg8::gemm_phase<pg8::EpiResid, pg8::StaticOrder, true, true>(lds, g, S, E);
    }
    SEAM(4);
    if (IN(5)) {
        for (int m = gw; m < MTOK; m += NGW) { f32x4 v[4];
#pragma unroll
            for (int j = 0; j < 4; ++j) v[j] = *((const f32x4*)(XF + (size_t)m * DM) + lane + 64 * j);
            ln_apply(v, ln_g + 0 * DM, ln_b + 0 * DM, lane); store_row_f32_bf16(v, XF + (size_t)m * DM, XB + (size_t)m * DM, lane); }
    }
    SEAM(5);
    if (IN(6)) {
        pg8::Gemm g{XB, W_FGU, MTOK, FGU_N, DM}; pg8::StaticOrder S; S.init(MTOK, FGU_N, G, bx);
        pg8::EpiSwiglu E{Hb, FGU_N / 256, 0};
        pg8::gemm_phase<pg8::EpiSwiglu, pg8::StaticOrder, true, true>(lds, g, S, E);
    }
    SEAM(6);
    if (IN(7)) {
        pg8::Gemm g{Hb, W_FDN, MTOK, DM, FF}; pg8::StaticOrder S; S.init(MTOK, DM, G, bx);
        pg8::EpiResid E{XF, XF, ALPHA};
        pg8::gemm_phase<pg8::EpiResid, pg8::StaticOrder, true, true>(lds, g, S, E);
    }
    SEAM(7);
    if (IN(8)) {
        for (int m = gw; m < MTOK; m += NGW) { f32x4 v[4];
#pragma unroll
            for (int j = 0; j < 4; ++j) v[j] = *((const f32x4*)(XF + (size_t)m * DM) + lane + 64 * j);
            ln_apply(v, ln_g + 1 * DM, ln_b + 1 * DM, lane); store_row_f32_bf16(v, XF + (size_t)m * DM, XB + (size_t)m * DM, lane); }
    }
    SEAM(8);
    if (IN(9)) {
        pg8::Gemm g{XB, W_OIN, MTOK, OIN_N, DM}; pg8::StaticOrder S; S.init(MTOK, OIN_N, G, bx);
        pg8::EpiOddIn E{CQ, CKV, KR};
        pg8::gemm_phase<pg8::EpiOddIn, pg8::StaticOrder, true, true>(lds, g, S, E);
    }
    SEAM(9);
    if (IN(10)) {
        const float* qg = args.in[I_QGAIN]; const float* kg = args.in[I_KVGAIN];
        for (int m = gw; m < MTOK; m += NGW) {
            const f32x4 cq = *((const f32x4*)(CQ + (size_t)m * 256) + lane);
            float ss = wave_sum((cq.x * cq.x + cq.y * cq.y) + (cq.z * cq.z + cq.w * cq.w));
            float rn = 1.0f / sqrtf(ss * (1.0f / 256.0f) + 1e-6f);
            const f32x4 g4 = *((const f32x4*)qg + lane);
            u32x2 w; w.x = pk2(cq.x * rn * g4.x, cq.y * rn * g4.y); w.y = pk2(cq.z * rn * g4.z, cq.w * rn * g4.w);
            *((u32x2*)(CQN + (size_t)m * 256) + lane) = w;
            const f32x2 ck = *((const f32x2*)(CKV + (size_t)m * 128) + lane);
            ss = wave_sum(ck.x * ck.x + ck.y * ck.y); rn = 1.0f / sqrtf(ss * (1.0f / 128.0f) + 1e-6f);
            const f32x2 g2 = *((const f32x2*)kg + lane);
            *((unsigned*)(CKVN + (size_t)m * 128) + lane) = pk2(ck.x * rn * g2.x, ck.y * rn * g2.y);
            const float val = KR[(size_t)m * 32 + (lane & 31)]; const float partner = __shfl_xor(val, 16);
            const int pos = m & (SEQ - 1), i = lane & 15; const float cs = ROPE[(pos * 16 + i) * 2], sn = ROPE[(pos * 16 + i) * 2 + 1];
            const float o = (lane & 16) ? (partner * sn + val * cs) : (val * cs - partner * sn);
            if (lane < 32) { const bf16 ob = (bf16)f2bf(o); bf16* kp = Kb + (size_t)m * 1536 + 64 + lane;
#pragma unroll
                for (int h = 0; h < 16; ++h) kp[h * 96] = ob; }
        }
    }
    SEAM(10);
    if (IN(11)) {
#ifndef SKIP_QUP
        { int kq = 256; asm volatile("" : "+s"(kq)); pg8::Gemm g{CQN, W_UQ, MTOK, UQ_N, kq}; pg8::StaticOrder S; S.init(MTOK, UQ_N, G, bx);
          pg8::EpiQUp E{Qb, ROPE, 0.10206207261596575f * LOG2E};
          pg8::gemm_phase<pg8::EpiQUp, pg8::StaticOrder, true, true>(lds, g, S, E); }
#endif
        __syncthreads();
#ifndef SKIP_KVUP
        { int kk = 128; asm volatile("" : "+s"(kk)); pg8::Gemm g{CKVN, W_UKV, MTOK, UKV_N, kk}; pg8::StaticOrder S; S.init(MTOK, UKV_N, G, bx);
          pg8::EpiKvUp E{Kb, VTb};
          pg8::gemm_phase<pg8::EpiKvUp, pg8::StaticOrder, true, true>(lds, g, S, E); }
#endif
    }
    SEAM(11);
    if (IN(12)) {
        const AttnP AP{Qb, Kb, VTb, AO2, nullptr, nullptr, nullptr};
        attn_phase<false>(lds, AP, G, bx, nullptr);
    }
    SEAM(12);
    if (IN(13)) {
        pg8::Gemm g{AO2, W_OOUT, MTOK, DM, DM}; pg8::StaticOrder S; S.init(MTOK, DM, G, bx);
        pg8::EpiResid E{XF, XF, ALPHA};
        pg8::gemm_phase<pg8::EpiResid, pg8::StaticOrder, true, true>(lds, g, S, E);
    }
    SEAM(13);
    if (IN(14)) {
        LAS int* cntL = (LAS int*)lds; const float* rw = args.in[I_ROUTER];
        for (int ch = bx; ch < MTOK / 64; ch += G) {
            if (tid < 8) cntL[tid] = 0;
            __syncthreads();
            for (int i = 0; i < 8; ++i) { const int m = 64 * ch + 8 * wave + i; f32x4 v[4];
#pragma unroll
                for (int j = 0; j < 4; ++j) v[j] = *((const f32x4*)(XF + (size_t)m * DM) + lane + 64 * j);
                ln_apply(v, ln_g + 2 * DM, ln_b + 2 * DM, lane); store_row_f32_bf16(v, XF + (size_t)m * DM, XB + (size_t)m * DM, lane);
                float lg[8];
#pragma unroll
                for (int e = 0; e < 8; ++e) lg[e] = 0.f;
#pragma unroll
                for (int j = 0; j < 4; ++j)
#pragma unroll
                    for (int e4 = 0; e4 < 4; ++e4) { const int d = 256 * j + 4 * lane + e4; const f32x4 r0 = *(const f32x4*)(rw + (size_t)d * 8), r1 = *(const f32x4*)(rw + (size_t)d * 8 + 4); const float xv = v[j][e4];
#pragma unroll
                        for (int e = 0; e < 4; ++e) { lg[e] += xv * r0[e]; lg[4 + e] += xv * r1[e]; } }
#pragma unroll
                for (int e = 0; e < 8; ++e) lg[e] = wave_sum(lg[e]);
                int e0 = 0; float v0 = lg[0];
#pragma unroll
                for (int e = 1; e < 8; ++e) if (lg[e] > v0) { v0 = lg[e]; e0 = e; }
                int e1 = -1; float v1 = -3.0e38f;
#pragma unroll
                for (int e = 0; e < 8; ++e) if (e != e0 && lg[e] > v1) { v1 = lg[e]; e1 = e; }
                const float w0 = 1.0f / (1.0f + __expf(v1 - v0)), w1 = 1.0f - w0;
                if (lane == 0) { TOKE[2 * m] = e0; TOKE[2 * m + 1] = e1; TOKW[2 * m] = w0; TOKW[2 * m + 1] = w1; atomicAdd((int*)(cntL + e0), 1); atomicAdd((int*)(cntL + e1), 1); }
            }
            __syncthreads();
            if (tid < 8) BLKCNT[ch * 8 + tid] = cntL[tid];
            __syncthreads();
        }
    }
    SEAM(14);
    if (IN(15)) {
        LAS int* cnt_all = (LAS int*)lds; LAS int* pre = cnt_all + 2048; LAS int* segb = pre + 8; LAS int* w0cnt = segb + 8; LAS int* posL = w0cnt + 8; LAS int* tot = posL + 128;
        for (int i = tid; i < 2048; i += NTHR) cnt_all[i] = BLKCNT[i];
        __syncthreads();
        if (tid < 8) { int s = 0; for (int c2 = 0; c2 < 256; ++c2) s += cnt_all[c2 * 8 + tid]; tot[tid] = s; }
        __syncthreads();
        if (tid == 0) { int rowb = 0; for (int e = 0; e < 8; ++e) { segb[e] = rowb; rowb += ((tot[e] + 255) >> 8) << 8; }
            if (bx == 0) { int t = 0; for (int e = 0; e < 8; ++e) { const int nt = (tot[e] + 255) >> 8; for (int k = 0; k < nt; ++k) TILEE[t++] = e; } TILEE[MAXT] = t; } }
        __syncthreads();
        for (int ch = bx; ch < MTOK / 64; ch += G) {
            if (tid < 8) { int s = 0; for (int c2 = 0; c2 < ch; ++c2) s += cnt_all[c2 * 8 + tid]; pre[tid] = s; }
            int e_mine = -1, rank = 0, token = 0, kk = 0;
            if (tid < 128) { token = 64 * ch + (tid >> 1); kk = tid & 1; e_mine = TOKE[2 * token + kk]; }
            if (wave < 2) {
#pragma unroll
                for (int e = 0; e < 8; ++e) { const unsigned long long mask = __ballot(e_mine == e); if (e_mine == e) rank = __popcll(mask & ((1ull << lane) - 1ull)); if (wave == 0 && lane == 0) w0cnt[e] = __popcll(mask); }
            }
            __syncthreads();
            if (tid < 128) { if (wave == 1) rank += w0cnt[e_mine]; const int pos = segb[e_mine] + pre[e_mine] + rank; posL[tid] = pos; POS[2 * token + kk] = pos; }
            __syncthreads();
            for (int en = wave; en < 128; en += 8) { const int tk = 64 * ch + (en >> 1); const int pos = posL[en];
                const u32x4* src = (const u32x4*)(XB + (size_t)tk * DM); u32x4* dst = (u32x4*)(XP + (size_t)pos * DM);
                const u32x4 a = src[lane], b2 = src[lane + 64]; dst[lane] = a; dst[lane + 64] = b2; }
            __syncthreads();
        }
    }
    SEAM(15);
#define MOE_GU(ph, PASS) if (IN(ph)) { const int T = TILEE[MAXT], T1 = T < 64 ? T : 64; const int t0 = (PASS) ? T1 : 0, t1 = (PASS) ? T : T1; \
        pg8::Gemm g{XP, W_MGU, 0, 0, DM}; pg8::MoeOrder S{t0, t1, FGU_N / 256, G, bx, FGU_N / 256, 0, TILEE}; pg8::EpiSwiglu E{HP, FGU_N / 256, t0}; \
        pg8::gemm_phase<pg8::EpiSwiglu, pg8::MoeOrder, true, true>(lds, g, S, E); }
#define MOE_DN(ph, PASS) if (IN(ph)) { const int T = TILEE[MAXT], T1 = T < 64 ? T : 64; const int t0 = (PASS) ? T1 : 0, t1 = (PASS) ? T : T1; \
        pg8::Gemm g{HP, W_MDN, 0, 0, FF}; pg8::MoeOrder S{t0, t1, 4, G, bx, 4, t0, TILEE}; pg8::EpiBf16Out E{XP, t0}; \
        pg8::gemm_phase<pg8::EpiBf16Out, pg8::MoeOrder, true, true>(lds, g, S, E); }
    MOE_GU(16, 0) SEAM(16);
    MOE_DN(17, 0) SEAM(17);
    MOE_GU(18, 1) SEAM(18);
    MOE_DN(19, 1) SEAM(19);
    if (IN(20)) {
        for (int m = gw; m < MTOK; m += NGW) {
            const int p0 = POS[2 * m], p1 = POS[2 * m + 1]; const float w0 = TOKW[2 * m], w1 = TOKW[2 * m + 1];
            f32x4 v[4];
#pragma unroll
            for (int j = 0; j < 4; ++j) { const f32x4 xv = *((const f32x4*)(XF + (size_t)m * DM) + lane + 64 * j);
                const u32x2 y0 = *((const u32x2*)(XP + (size_t)p0 * DM) + lane + 64 * j), y1 = *((const u32x2*)(XP + (size_t)p1 * DM) + lane + 64 * j);
                f32x4 a, b2; a.x = __builtin_bit_cast(float, y0.x << 16); a.y = __builtin_bit_cast(float, y0.x & 0xffff0000u); a.z = __builtin_bit_cast(float, y0.y << 16); a.w = __builtin_bit_cast(float, y0.y & 0xffff0000u);
                b2.x = __builtin_bit_cast(float, y1.x << 16); b2.y = __builtin_bit_cast(float, y1.x & 0xffff0000u); b2.z = __builtin_bit_cast(float, y1.y << 16); b2.w = __builtin_bit_cast(float, y1.y & 0xffff0000u);
                v[j] = xv * ALPHA + a * w0 + b2 * w1; }
            ln_apply(v, ln_g + 3 * DM, ln_b + 3 * DM, lane);
            GAS f32x4* fr = (GAS f32x4*)(XF + (size_t)m * DM) + lane;
#pragma unroll
            for (int j = 0; j < 4; ++j) fr[64 * j] = v[j];
        }
    }
#undef IN
#undef SEAM
}

extern "C" void kernel_launch(void* const* d_in, const int* in_sizes, int n_in, void* d_out, int out_size, void* d_ws, size_t ws_size, hipStream_t stream) {
    static int grid = 0;
    if (grid == 0) {
        if (n_in != 24 || out_size != MTOK * DM || ws_size < WS_END) { fprintf(stderr, "kernel_launch: unexpected problem (n_in %d, out %d, ws %zu)\n", n_in, out_size, ws_size); grid = -1; return; }
        int dev = 0, cus = 0, per_cu = 0;
        if (hipGetDevice(&dev) != hipSuccess || hipDeviceGetAttribute(&cus, hipDeviceAttributeMultiprocessorCount, dev) != hipSuccess) { grid = -1; return; }
        if (hipFuncSetAttribute((const void*)mega_fwd, hipFuncAttributeMaxDynamicSharedMemorySize, LDS_BYTES) != hipSuccess) { fprintf(stderr, "kernel_launch: hipFuncSetAttribute failed\n"); grid = -1; return; }
        if (hipOccupancyMaxActiveBlocksPerMultiprocessor(&per_cu, (const void*)mega_fwd, NTHR, LDS_BYTES) != hipSuccess || per_cu < 1) { fprintf(stderr, "kernel_launch: occupancy query says %d\n", per_cu); }
        (void)hipGetLastError();
        grid = cus;
    }
    if (grid < 0) return;
    if (hipMemsetAsync((char*)d_ws + WS_CTL, 0, CTL_ZERO_BYTES, stream) != hipSuccess) return;
    Args a{};
    for (int i = 0; i < 24; ++i) a.in[i] = (const float*)d_in[i];
    a.out = (float*)d_out; a.ws = (unsigned char*)d_ws;
#if MK_PER_PHASE
    for (int p = 0; p < NPHASE; ++p) { a.ph_lo = p; a.ph_hi = p + 1; a.flags = 0; hipLaunchKernelGGL(mega_fwd, dim3(grid), dim3(NTHR), LDS_BYTES, stream, a);
#ifdef PROBE_REP
        if (p == PROBE_REP) for (int rr = 0; rr < PROBE_N; ++rr) { a.flags = PROBE_FLAGS; hipLaunchKernelGGL(mega_fwd, dim3(grid), dim3(NTHR), LDS_BYTES, stream, a); }
#endif
    }
#else
    a.ph_lo = 0; a.ph_hi = NPHASE; hipLaunchKernelGGL(mega_fwd, dim3(grid), dim3(NTHR), LDS_BYTES, stream, a);
#endif
}
```
